# Optimizing an MI355X kernel written in HIP

```python
import math
import jax, jax.numpy as jnp
from jax import lax
import numpy as np

D_MODEL = 1024
BATCH = 8
SEQ = 2048
DEPTH = 1
DEC_BATCH = 128
DEC_SEQ = 8
PAST_LEN = 2048
PAGE_SIZE = 128

POOL_WIDTH = D_MODEL // 2
POOL_WINDOWS = (2, 4, 8, 16)
N_POOL_GROUPS = len(POOL_WINDOWS)
POOL_GROUP_DIM = POOL_WIDTH // N_POOL_GROUPS
POOL_STATE = max(POOL_WINDOWS) - 1
N_HEADS = 4
HEAD_DIM = 64
V_HEAD_DIM = 2 * HEAD_DIM
QK_WIDTH = N_HEADS * 2 * HEAD_DIM
ATTN_WIDTH = N_HEADS * V_HEAD_DIM
PROJ_WIDTH = POOL_WIDTH + 2 * QK_WIDTH + ATTN_WIDTH
D_FF = 2816
CONV_WIDTH = 3
N_BUCKETS = 32
MAX_DISTANCE = 128
QBLOCK = 128
N_MOD = 6
EPS = 1e-6

kernel_name = "hymba_pool_diffattn_convffn_step"


def rmsnorm(x, g):
    xf = x.astype(jnp.float32)
    y = xf * lax.rsqrt(jnp.mean(xf * xf, axis=-1, keepdims=True) + EPS)
    return (y * g.astype(jnp.float32)).astype(x.dtype)


def rel_bucket(dist):
    max_exact = N_BUCKETS // 2
    d = jnp.maximum(dist, 1).astype(jnp.float32)
    large = max_exact + (jnp.log(d / max_exact) / math.log(MAX_DISTANCE / max_exact)
                         * (N_BUCKETS - max_exact)).astype(jnp.int32)
    large = jnp.minimum(large, N_BUCKETS - 1)
    return jnp.where(dist < max_exact, dist, large)


def diff_attend(q, k, v, q_pos, k_pos, rel_bias, lam):
    s = jnp.einsum('bqhcd,bkhcd->bhcqk', q, k,
                   preferred_element_type=jnp.float32) * (HEAD_DIM ** -0.5)
    dist = q_pos[:, None] - k_pos[None, :]
    bias = rel_bias.astype(jnp.float32)[rel_bucket(jnp.maximum(dist, 0))]
    s = s + jnp.transpose(bias, (2, 0, 1))[None, :, None]
    s = jnp.where((dist >= 0)[None, None, None], s, -jnp.inf)
    p = jax.nn.softmax(s, axis=-1)
    a = p[:, :, 0] - lam * p[:, :, 1]
    return jnp.einsum('bhqk,bkhd->bqhd', a.astype(v.dtype), v)


def causal_attention(q, k_all, v_all, pos0, rel_bias, lam):
    B, T = q.shape[0], q.shape[1]
    k_pos = jnp.arange(k_all.shape[1], dtype=jnp.int32)
    q_pos = pos0 + jnp.arange(T, dtype=jnp.int32)
    if T % QBLOCK == 0 and T > QBLOCK:
        def block(i):
            qb = lax.dynamic_slice_in_dim(q, i * QBLOCK, QBLOCK, axis=1)
            pb = lax.dynamic_slice_in_dim(q_pos, i * QBLOCK, QBLOCK)
            return diff_attend(qb, k_all, v_all, pb, k_pos, rel_bias, lam)
        o = lax.map(block, jnp.arange(T // QBLOCK))
        return jnp.moveaxis(o, 0, 1).reshape(B, T, N_HEADS, V_HEAD_DIM)
    return diff_attend(q, k_all, v_all, q_pos, k_pos, rel_bias, lam)


def pool_mix(u, prefix, pos0, w_pool, pool_scale):
    B, T = u.shape[0], u.shape[1]
    ext = jnp.concatenate([prefix, u], axis=1)
    extf = ext.astype(jnp.float32)
    cs = jnp.concatenate([jnp.zeros((B, 1, POOL_WIDTH), jnp.float32),
                          jnp.cumsum(extf, axis=1)], axis=1)
    pos = pos0 + jnp.arange(T, dtype=jnp.int32)
    outs = []
    for g, w in enumerate(POOL_WINDOWS):
        sl = slice(g * POOL_GROUP_DIM, (g + 1) * POOL_GROUP_DIM)
        hi = cs[:, POOL_STATE + 1:, sl]
        lo = cs[:, POOL_STATE + 1 - w:POOL_STATE + 1 - w + T, sl]
        cnt = jnp.minimum(pos + 1, w).astype(jnp.float32)[None, :, None]
        outs.append((hi - lo) / cnt - extf[:, POOL_STATE:, sl])
    d = jnp.stack(outs, axis=2).astype(u.dtype)
    y = jnp.einsum('btgc,gcd->btgd', d, w_pool).reshape(B, T, POOL_WIDTH)
    return y * pool_scale, ext[:, -POOL_STATE:]


def causal_dwconv(u, prefix, w, b):
    T = u.shape[1]
    ext = jnp.concatenate([prefix, u], axis=1)
    y = b + w[0] * ext[:, 0:T]
    for j in range(1, CONV_WIDTH):
        y = y + w[j] * ext[:, j:j + T]
    return y, ext[:, -(CONV_WIDTH - 1):]


def layer(x, c, pos0, pool_prefix, conv_prefix, k_past, v_past, lam_init,
          w_ada, b_ada, g_pre_mix, g_post_mix, g_pre_ffn, g_post_ffn, w_in, w_out,
          w_pool, pool_scale, lam_q1, lam_k1, lam_q2, lam_k2, g_head, rel_bias,
          w_up, conv_w, conv_b, w_down):
    B, T = x.shape[0], x.shape[1]
    mod = jax.nn.silu(c) @ w_ada + b_ada
    sh1, sc1, gt1, sh2, sc2, gt2 = [m[:, None] for m in jnp.split(mod, N_MOD, axis=-1)]
    h = rmsnorm(x, g_pre_mix) * (1 + sc1) + sh1
    z = h @ w_in
    u_pool, q, k, v = jnp.split(z, [POOL_WIDTH, POOL_WIDTH + QK_WIDTH,
                                    POOL_WIDTH + 2 * QK_WIDTH], axis=-1)
    q = q.reshape(B, T, N_HEADS, 2, HEAD_DIM)
    k = k.reshape(B, T, N_HEADS, 2, HEAD_DIM)
    v = v.reshape(B, T, N_HEADS, V_HEAD_DIM)
    y_pool, pool_state = pool_mix(u_pool, pool_prefix, pos0, w_pool, pool_scale)
    lam = (jnp.exp(jnp.sum(lam_q1.astype(jnp.float32) * lam_k1.astype(jnp.float32)))
           - jnp.exp(jnp.sum(lam_q2.astype(jnp.float32) * lam_k2.astype(jnp.float32)))
           + lam_init)
    k_all = k if k_past is None else jnp.concatenate([k_past, k], axis=1)
    v_all = v if v_past is None else jnp.concatenate([v_past, v], axis=1)
    o = causal_attention(q, k_all, v_all, pos0, rel_bias, lam)
    o = rmsnorm(o, g_head) * (1.0 - lam_init)
    mix = jnp.concatenate([y_pool, o.reshape(B, T, ATTN_WIDTH)], axis=-1) @ w_out
    x = x + gt1 * rmsnorm(mix, g_post_mix)
    h2 = rmsnorm(x, g_pre_ffn) * (1 + sc2) + sh2
    up, conv_state = causal_dwconv(h2 @ w_up, conv_prefix, conv_w, conv_b)
    gate, val = jnp.split(up, 2, axis=-1)
    f = (jax.nn.gelu(gate, approximate=True) * val) @ w_down
    x = x + gt2 * rmsnorm(f, g_post_ffn)
    return x, k, v, pool_state, conv_state


def setup_inputs(seed: int = 0) -> dict:
    key = jax.random.key(seed)
    ks = jax.random.split(key, 32)
    f32 = jnp.float32
    n_pages = PAST_LEN // PAGE_SIZE
    n_phys = (DEC_BATCH * n_pages * 5) // 4
    nrm = lambda k, shape, s: jax.random.normal(k, shape, f32) * s
    page_table = jax.random.permutation(ks[6], n_phys)[:DEC_BATCH * n_pages]
    page_table = page_table.reshape(DEC_BATCH, n_pages).astype(jnp.int32)
    return {
        "x_prompt": nrm(ks[0], (BATCH, SEQ, D_MODEL), 1.0),
        "x_sample": nrm(ks[1], (DEC_BATCH, DEC_SEQ, D_MODEL), 1.0),
        "c_prompt": nrm(ks[2], (BATCH, D_MODEL), 1.0),
        "c_sample": nrm(ks[3], (DEC_BATCH, D_MODEL), 1.0),
        "cache_k": nrm(ks[4], (DEPTH, n_phys, PAGE_SIZE, N_HEADS, 2, HEAD_DIM), 1.0),
        "cache_v": nrm(ks[5], (DEPTH, n_phys, PAGE_SIZE, N_HEADS, V_HEAD_DIM), 1.0),
        "page_table": page_table,
        "state_pool": nrm(ks[7], (DEPTH, DEC_BATCH, POOL_STATE, POOL_WIDTH), 1.0),
        "state_conv": nrm(ks[8], (DEPTH, DEC_BATCH, CONV_WIDTH - 1, 2 * D_FF), 1.0),
        "w_ada": nrm(ks[9], (DEPTH, D_MODEL, N_MOD * D_MODEL), 0.5 * D_MODEL ** -0.5),
        "b_ada": nrm(ks[10], (DEPTH, N_MOD * D_MODEL), 0.02),
        "g_pre_mix": 1.0 + nrm(ks[11], (DEPTH, D_MODEL), 0.02),
        "g_post_mix": 1.0 + nrm(ks[12], (DEPTH, D_MODEL), 0.02),
        "g_pre_ffn": 1.0 + nrm(ks[13], (DEPTH, D_MODEL), 0.02),
        "g_post_ffn": 1.0 + nrm(ks[14], (DEPTH, D_MODEL), 0.02),
        "w_in": nrm(ks[15], (DEPTH, D_MODEL, PROJ_WIDTH), D_MODEL ** -0.5),
        "w_out": nrm(ks[16], (DEPTH, POOL_WIDTH + ATTN_WIDTH, D_MODEL), (POOL_WIDTH + ATTN_WIDTH) ** -0.5),
        "w_pool": nrm(ks[17], (DEPTH, N_POOL_GROUPS, POOL_GROUP_DIM, POOL_GROUP_DIM), POOL_GROUP_DIM ** -0.5),
        "pool_scale": 1.0 + nrm(ks[18], (DEPTH, POOL_WIDTH), 0.1),
        "lam_q1": nrm(ks[19], (DEPTH, HEAD_DIM), 0.1),
        "lam_k1": nrm(ks[20], (DEPTH, HEAD_DIM), 0.1),
        "lam_q2": nrm(ks[21], (DEPTH, HEAD_DIM), 0.1),
        "lam_k2": nrm(ks[22], (DEPTH, HEAD_DIM), 0.1),
        "g_head": 1.0 + nrm(ks[23], (DEPTH, V_HEAD_DIM), 0.02),
        "rel_bias": nrm(ks[24], (N_BUCKETS, N_HEADS), 0.5),
        "w_up": nrm(ks[25], (DEPTH, D_MODEL, 2 * D_FF), D_MODEL ** -0.5),
        "conv_w": nrm(ks[26], (DEPTH, CONV_WIDTH, 2 * D_FF), CONV_WIDTH ** -0.5),
        "conv_b": nrm(ks[27], (DEPTH, 2 * D_FF), 0.02),
        "w_down": nrm(ks[28], (DEPTH, D_FF, D_MODEL), D_FF ** -0.5),
    }


def reference(x_prompt, x_sample, c_prompt, c_sample, cache_k, cache_v, page_table,
              state_pool, state_conv, w_ada, b_ada, g_pre_mix, g_post_mix, g_pre_ffn,
              g_post_ffn, w_in, w_out, w_pool, pool_scale, lam_q1, lam_k1, lam_q2, lam_k2,
              g_head, rel_bias, w_up, conv_w, conv_b, w_down):
    n_dec = page_table.shape[0]
    past_len = page_table.shape[1] * cache_k.shape[2]
    xp, xs = x_prompt, x_sample
    kp_l, vp_l, pp_l, cp_l = [], [], [], []
    ks_l, vs_l, ps_l, cs_l = [], [], [], []
    for l in range(DEPTH):
        lam_init = 0.8 - 0.6 * math.exp(-0.3 * l)
        params = (w_ada[l], b_ada[l], g_pre_mix[l], g_post_mix[l], g_pre_ffn[l], g_post_ffn[l],
                  w_in[l], w_out[l], w_pool[l], pool_scale[l], lam_q1[l], lam_k1[l],
                  lam_q2[l], lam_k2[l], g_head[l], rel_bias, w_up[l], conv_w[l], conv_b[l],
                  w_down[l])
        pool0 = jnp.zeros((xp.shape[0], POOL_STATE, POOL_WIDTH), xp.dtype)
        conv0 = jnp.zeros((xp.shape[0], CONV_WIDTH - 1, 2 * D_FF), xp.dtype)
        xp, kp, vp, pp, cp = layer(xp, c_prompt, 0, pool0, conv0, None, None, lam_init, *params)
        k_past = cache_k[l][page_table].reshape(n_dec, past_len, N_HEADS, 2, HEAD_DIM)
        v_past = cache_v[l][page_table].reshape(n_dec, past_len, N_HEADS, V_HEAD_DIM)
        xs, ksn, vsn, psn, csn = layer(xs, c_sample, past_len, state_pool[l], state_conv[l],
                                       k_past, v_past, lam_init, *params)
        kp_l.append(kp); vp_l.append(vp); pp_l.append(pp); cp_l.append(cp)
        ks_l.append(ksn); vs_l.append(vsn); ps_l.append(psn); cs_l.append(csn)
    return (xp, xs,
            jnp.stack(kp_l), jnp.stack(vp_l), jnp.stack(pp_l), jnp.stack(cp_l),
            jnp.stack(ks_l), jnp.stack(vs_l), jnp.stack(ps_l), jnp.stack(cs_l))
```

```cpp
#include <hip/hip_runtime.h>
#include <hip/hip_bf16.h>
#include <cstdio>
#include <cstdint>
#include <cmath>
namespace pg8 {
#define PG8_LAS __attribute__((address_space(3)))
typedef unsigned short bf16_t;
typedef short bf16x8 __attribute__((ext_vector_type(8)));
typedef float f32x4 __attribute__((ext_vector_type(4)));
typedef unsigned u32x4 __attribute__((ext_vector_type(4)));
constexpr int BM = 256, BK = 64, HALF = 128, HTB = HALF * BK * 2  , STAGE_BYTES = 8 * HTB, NXCD = 8, WGM = 8;

__host__ __device__ __forceinline__ int lds_byte(int r, int c) { const int st = (r >> 4) * 2 + (c >> 5), rr = r & 15, cc = c & 31, ob = rr * 64 + cc * 2; return st * 1024 + (ob ^ (((ob >> 9) & 1) << 5)); }
__host__ __device__ __forceinline__ void stage_rc(int b, int& R, int& C) { const int st = b / 1024, sb = b % 1024, swz = sb ^ (((sb >> 9) & 1) << 5); R = (st >> 1) * 16 + swz / 64; C = (st & 1) * 32 + (swz % 64) / 2; }
__host__ __device__ __forceinline__ int perm32(int rho) { const int n = rho >> 4, i = rho & 15; return 8 * (i >> 2) + 4 * n + (i & 3); }

struct Unit { int pm, pn; };
struct Gemm { const bf16_t* A; const bf16_t* Bt; int M, N, K; };

struct StaticOrder {
    int nM, nN, nwg, G, c;
    __host__ __device__ void init(int M, int N, int G_, int c_) { nM = M / BM; nN = N / BM; nwg = nM * nN; G = G_; c = c_; }
    __host__ __device__ bool next(int i, Unit& u) const {
        const long L = (long)i * G + c; if (L >= nwg) return false;
        int wgid = (int)L; { const int q = nwg / NXCD, r = nwg % NXCD, xcd = wgid % NXCD, off = wgid / NXCD; wgid = (xcd < r ? xcd * (q + 1) : r * (q + 1) + (xcd - r) * q) + off; }
        const int nig = WGM * nN, gid = wgid / nig, fm = gid * WGM, gsz = (nM - fm) < WGM ? (nM - fm) : WGM;
        u.pm = fm + ((wgid % nig) % gsz); u.pn = (wgid % nig) / gsz; return true;
    }
    __device__ __forceinline__ void a_ready(const Unit&) const {}
    __device__ __forceinline__ void done(const Unit&) const {}
};

__device__ __forceinline__ unsigned cvt_pk_bf16(float lo, float hi) { unsigned r; asm volatile("v_cvt_pk_bf16_f32 %0, %1, %2" : "=v"(r) : "v"(lo), "v"(hi)); return r; }
typedef float f32x2 __attribute__((ext_vector_type(2)));
__device__ __forceinline__ f32x2 gelu_pk(f32x2 v) {
    const f32x2 av = __builtin_elementwise_abs(v), d = av * 0.2316418882f + 1.0f;
    f32x2 t; t.x = __builtin_amdgcn_rcpf(d.x); t.y = __builtin_amdgcn_rcpf(d.y);
    f32x2 q = t * 0.5307027145f + (-0.7265760135f); q = q * t + 0.7107068705f; q = q * t + (-0.142248368f); q = q * t + 0.127414796f; q = q * t;
    const f32x2 s = (v * v) * (-0.72134752044f);
    f32x2 e; e.x = __builtin_amdgcn_exp2f(s.x); e.y = __builtin_amdgcn_exp2f(s.y);
    const f32x2 m = v * (q * e), r = v - m;
    f32x2 o; o.x = v.x < 0.f ? m.x : r.x; o.y = v.y < 0.f ? m.y : r.y; return o;
}

template <int ACT  > struct EpiBf16 {
    static constexpr bool PERM = true, AFTER_DRAIN = false; static_assert(ACT == 0 || ACT == 1, "EpiBf16: ACT is 0 (none) or 1 (gelu_pk)");
    bf16_t* O; int ldc; const float* bias; int split_cols; size_t split_stride; float scale0;
    __device__ __forceinline__ void operator()(const f32x4 (&acc)[2][2][4][2], const Unit& u, int wr, int wc, int fr, int fq) const {
        const int row0 = u.pm * BM + wr * 64 + fr; int colt = u.pn * BM; bf16_t* base = O;
        float sc = 1.f; if (split_cols) { const int t = colt / split_cols; base += (size_t)t * split_stride; colt -= t * split_cols; if (t == 0) sc = scale0; }
        const int col0 = colt + wc * 32 + 8 * fq, bcol0 = u.pn * BM + wc * 32 + 8 * fq;
        f32x4 bv[2][2];
#pragma unroll
        for (int bj = 0; bj < 2; ++bj)
#pragma unroll
            for (int n = 0; n < 2; ++n) bv[bj][n] = bias ? *(const f32x4*)(bias + bcol0 + bj * HALF + 4 * n) : (f32x4){0.f, 0.f, 0.f, 0.f};
#pragma unroll
        for (int ai = 0; ai < 2; ++ai)
#pragma unroll
            for (int m = 0; m < 4; ++m) { bf16_t* rowp = base + (size_t)(row0 + ai * HALF + m * 16) * ldc + col0;
#pragma unroll
                for (int bj = 0; bj < 2; ++bj) { f32x4 v0 = acc[ai][bj][m][0] + bv[bj][0], v1 = acc[ai][bj][m][1] + bv[bj][1];
                    if (ACT == 1) { f32x2 a = gelu_pk((f32x2){v0[0], v0[1]}), b = gelu_pk((f32x2){v0[2], v0[3]}), c = gelu_pk((f32x2){v1[0], v1[1]}), d = gelu_pk((f32x2){v1[2], v1[3]});
                        v0 = (f32x4){a.x, a.y, b.x, b.y}; v1 = (f32x4){c.x, c.y, d.x, d.y}; }
                    v0 = v0 * sc; v1 = v1 * sc; u32x4 w; w.x = cvt_pk_bf16(v0[0], v0[1]); w.y = cvt_pk_bf16(v0[2], v0[3]); w.z = cvt_pk_bf16(v1[0], v1[1]); w.w = cvt_pk_bf16(v1[2], v1[3]);
                    *(u32x4*)(rowp + bj * HALF) = w; } }
    }
};
template <class Epi, class Sched, bool ALIGN_EPI = false, bool SP2 = false>
__device__ __forceinline__ void gemm_phase(PG8_LAS unsigned char* lds, const Gemm g, const Sched& S, const Epi& E) {
    const int tid = threadIdx.x, wid = __builtin_amdgcn_readfirstlane(tid >> 6), lane = tid & 63, wr = wid >> 2, wc = wid & 3, fr = lane & 15, fq = lane >> 4;
    const int K = g.K, nt = K / BK;
    unsigned voffA[2], voffB[2];
#pragma unroll
    for (int i = 0; i < 2; ++i) { int R, C; stage_rc(tid * 16 + i * 8192, R, C); const int Rb = Epi::PERM ? ((R & ~31) + perm32(R & 31)) : R;
        voffA[i] = (unsigned)(R * K + C) * 2u; voffB[i] = (unsigned)(Rb * K + C) * 2u; }
    const size_t kstep = (size_t)(BK * 2);
    const size_t hstep = (size_t)HALF * K * 2;
    const size_t tstep = 2 * hstep;
    const unsigned ldsw = (unsigned)wid * 1024u;
    const int aoff = lds_byte(wr * 64 + fr, fq * 8), boff = lds_byte(wc * 32 + fr, fq * 8);
#define PG8_SA(b, h) (((b) * 2 + (h)) * HTB)
#define PG8_SB(b, h) ((4 + (b) * 2 + (h)) * HTB)
#define PG8_STAGE(bufoff, gbase, voff) do { _Pragma("unroll") for (int _i = 0; _i < 2; ++_i) \
        __builtin_amdgcn_global_load_lds((const unsigned*)((const char*)(gbase) + (voff)[_i]), (PG8_LAS unsigned*)(lds + (bufoff) + ldsw + _i * 8192), 16, 0, 0); } while (0)
#define PG8_LDA(dst, b, h) do { _Pragma("unroll") for (int m = 0; m < 4; ++m) _Pragma("unroll") for (int k = 0; k < 2; ++k) dst[m][k] = *(const PG8_LAS bf16x8*)(lds + PG8_SA(b, h) + aoff + m * 2048 + k * 1024); } while (0)
#define PG8_LDB(dst, b, h) do { _Pragma("unroll") for (int n = 0; n < 2; ++n) _Pragma("unroll") for (int k = 0; k < 2; ++k) dst[n][k] = *(const PG8_LAS bf16x8*)(lds + PG8_SB(b, h) + boff + n * 2048 + k * 1024); } while (0)
#define PG8_MMA(ai, bj, At, Bt) do { __builtin_amdgcn_s_setprio(1); _Pragma("unroll") for (int m = 0; m < 4; ++m) _Pragma("unroll") for (int n = 0; n < 2; ++n) _Pragma("unroll") for (int k = 0; k < 2; ++k) \
        acc[ai][bj][m][n] = __builtin_amdgcn_mfma_f32_16x16x32_bf16(Bt[n][k], At[m][k], acc[ai][bj][m][n], 0, 0, 0); __builtin_amdgcn_s_setprio(0); } while (0)
#define PG8_WAIT_V(n) asm volatile("s_waitcnt vmcnt(" #n ")" ::: "memory")
#define PG8_WAIT_L(n) asm volatile("s_waitcnt lgkmcnt(" #n ")" ::: "memory")
#define PG8_BAR __builtin_amdgcn_s_barrier()
#define PG8_SCHED __builtin_amdgcn_sched_barrier(0)
    Unit cur, nxt; int ui = 0;
    if (!S.next(0, cur)) return;
    f32x4 acc[2][2][4][2];
#pragma unroll
    for (int a = 0; a < 2; ++a)
#pragma unroll
        for (int b = 0; b < 2; ++b)
#pragma unroll
            for (int m = 0; m < 4; ++m)
#pragma unroll
                for (int n = 0; n < 2; ++n) acc[a][b][m][n] = (f32x4){0.f, 0.f, 0.f, 0.f};
    bf16x8 At[4][2], B0[2][2], B1[2][2];
    const char* cA = (const char*)g.A + (size_t)cur.pm * tstep; const char* cB = (const char*)g.Bt + (size_t)cur.pn * tstep;
    S.a_ready(cur);
    if constexpr (SP2) {
        PG8_STAGE(PG8_SB(0, 0), cB, voffB); PG8_STAGE(PG8_SB(0, 1), cB + hstep, voffB); PG8_STAGE(PG8_SA(0, 0), cA, voffA); PG8_STAGE(PG8_SA(0, 1), cA + hstep, voffA);
        if (wr == 1) PG8_BAR;
        PG8_WAIT_V(2); PG8_BAR;
        PG8_STAGE(PG8_SB(1, 0), cB + kstep, voffB); PG8_STAGE(PG8_SA(1, 0), cA + kstep, voffA); PG8_STAGE(PG8_SB(1, 1), cB + hstep + kstep, voffB);
        PG8_WAIT_V(6); PG8_BAR;
    } else {
        PG8_STAGE(PG8_SB(0, 0), cB, voffB); PG8_STAGE(PG8_SA(0, 0), cA, voffA); PG8_STAGE(PG8_SB(0, 1), cB + hstep, voffB); PG8_STAGE(PG8_SA(0, 1), cA + hstep, voffA);
        if (wr == 1) PG8_BAR;
        PG8_WAIT_V(4); PG8_BAR;
        PG8_STAGE(PG8_SB(1, 0), cB + kstep, voffB); PG8_STAGE(PG8_SA(1, 0), cA + kstep, voffA); PG8_STAGE(PG8_SB(1, 1), cB + hstep + kstep, voffB);
        PG8_WAIT_V(6); PG8_BAR;
    }
    for (;;) {
        const bool has_next = S.next(ui + 1, nxt);
        const char* nA = has_next ? (const char*)g.A + (size_t)nxt.pm * tstep : cA; const char* nB = has_next ? (const char*)g.Bt + (size_t)nxt.pn * tstep : cB;
        for (int t = 0; t < nt; t += 2) {
            const bool last = (t == nt - 2);
            const char* a1 = cA + (size_t)(t + 1) * kstep;
            const char* a2 = last ? nA : cA + (size_t)(t + 2) * kstep; const char* b2 = last ? nB : cB + (size_t)(t + 2) * kstep;
            const char* a3 = a2 + kstep; const char* b3 = b2 + kstep;
            if (last && has_next) S.a_ready(nxt);
            if constexpr (SP2) {
            PG8_LDB(B0, 0, 0); PG8_LDB(B1, 0, 1); PG8_SCHED; PG8_LDA(At, 0, 0); PG8_STAGE(PG8_SA(1, 1), a1 + hstep, voffA);
            PG8_WAIT_V(8); PG8_WAIT_L(0); PG8_BAR; PG8_MMA(0, 0, At, B0); PG8_MMA(0, 1, At, B1); PG8_BAR; PG8_SCHED;
            PG8_LDA(At, 0, 1); PG8_STAGE(PG8_SB(0, 0), b2, voffB); PG8_STAGE(PG8_SB(0, 1), b2 + hstep, voffB); PG8_STAGE(PG8_SA(0, 0), a2, voffA);
            PG8_WAIT_V(8); PG8_WAIT_L(0); PG8_BAR; PG8_MMA(1, 0, At, B0); PG8_MMA(1, 1, At, B1); PG8_BAR; PG8_SCHED;
            PG8_LDB(B0, 1, 0); PG8_LDB(B1, 1, 1); PG8_SCHED; PG8_LDA(At, 1, 0); PG8_STAGE(PG8_SA(0, 1), a2 + hstep, voffA);
            PG8_WAIT_V(8); PG8_WAIT_L(0); PG8_BAR; PG8_MMA(0, 0, At, B0); PG8_MMA(0, 1, At, B1); PG8_BAR; PG8_SCHED;
            PG8_LDA(At, 1, 1); PG8_STAGE(PG8_SB(1, 0), b3, voffB); PG8_STAGE(PG8_SB(1, 1), b3 + hstep, voffB); PG8_STAGE(PG8_SA(1, 0), a3, voffA);
            PG8_WAIT_V(8); PG8_WAIT_L(0); PG8_BAR; PG8_MMA(1, 0, At, B0); PG8_MMA(1, 1, At, B1); PG8_BAR; PG8_SCHED;
            } else {
            PG8_LDB(B0, 0, 0); PG8_SCHED; PG8_LDA(At, 0, 0); PG8_STAGE(PG8_SA(1, 1), a1 + hstep, voffA);
            PG8_WAIT_L(8); PG8_BAR; PG8_WAIT_L(0); PG8_MMA(0, 0, At, B0); PG8_BAR; PG8_SCHED;
            PG8_LDB(B1, 0, 1); PG8_STAGE(PG8_SB(0, 0), b2, voffB);
            PG8_BAR; PG8_WAIT_L(0); PG8_MMA(0, 1, At, B1); PG8_BAR;
            PG8_LDA(At, 0, 1); PG8_STAGE(PG8_SA(0, 0), a2, voffA);
            PG8_BAR; PG8_WAIT_L(0); PG8_MMA(1, 0, At, B0); PG8_BAR; PG8_SCHED;
            PG8_STAGE(PG8_SB(0, 1), b2 + hstep, voffB);
            PG8_WAIT_V(6); PG8_BAR; PG8_MMA(1, 1, At, B1); PG8_BAR;
            PG8_LDB(B0, 1, 0); PG8_SCHED; PG8_LDA(At, 1, 0); PG8_STAGE(PG8_SA(0, 1), a2 + hstep, voffA);
            PG8_WAIT_L(8); PG8_BAR; PG8_WAIT_L(0); PG8_MMA(0, 0, At, B0); PG8_BAR; PG8_SCHED;
            PG8_LDB(B1, 1, 1); PG8_STAGE(PG8_SB(1, 0), b3, voffB);
            PG8_BAR; PG8_WAIT_L(0); PG8_MMA(0, 1, At, B1); PG8_BAR;
            PG8_LDA(At, 1, 1); PG8_STAGE(PG8_SA(1, 0), a3, voffA);
            PG8_BAR; PG8_WAIT_L(0); PG8_MMA(1, 0, At, B0); PG8_BAR; PG8_SCHED;
            PG8_STAGE(PG8_SB(1, 1), b3 + hstep, voffB);
            PG8_WAIT_V(6); PG8_BAR; PG8_MMA(1, 1, At, B1); PG8_BAR;
            }
        }
        if constexpr (ALIGN_EPI) { if (wr == 0) PG8_BAR; }
        if constexpr (!Epi::AFTER_DRAIN) { E(acc, cur, wr, wc, fr, fq); S.done(cur); }
        if (!has_next) break;
#pragma unroll
        for (int a = 0; a < 2; ++a)
#pragma unroll
            for (int b = 0; b < 2; ++b)
#pragma unroll
                for (int m = 0; m < 4; ++m)
#pragma unroll
                    for (int n = 0; n < 2; ++n) acc[a][b][m][n] = (f32x4){0.f, 0.f, 0.f, 0.f};
        cur = nxt; cA = nA; cB = nB; ++ui;
        if constexpr (ALIGN_EPI) { if (wr == 1) PG8_BAR; }
    }
    PG8_WAIT_V(0);
    if constexpr (!ALIGN_EPI) { if (wr == 0) PG8_BAR; }
    PG8_BAR;
    if constexpr (Epi::AFTER_DRAIN) { E.fused(acc, cur, wr, wc, fr, fq, lds, wid, lane); S.done(cur); }
#undef PG8_SA
#undef PG8_SB
#undef PG8_STAGE
#undef PG8_LDA
#undef PG8_LDB
#undef PG8_MMA
#undef PG8_WAIT_V
#undef PG8_WAIT_L
#undef PG8_BAR
#undef PG8_SCHED
}
}
constexpr int D = 1024, NBP = 8, TP = 2048, NBS = 128, TS = 8;
constexpr int MP = NBP * TP, MS = NBS * TS, M = MP + MS;
constexpr int PROJ = 2048, FF = 2816, UPW = 2 * FF, MODW = 6 * D, NMOD = NBP + NBS;
constexpr int PAGE = 128, NPAGES = 16, PAST = 2048;
constexpr float EPS = 1e-6f, LAM_INIT = 0.2f, LOG2E = 1.4426950408889634f;
constexpr float QSCALE = 0.125f * LOG2E;
constexpr size_t O_Y = 0, O_KP = (size_t)M * D, O_VP = O_KP + (size_t)MP * 512, O_PP = O_VP + (size_t)MP * 512, O_CP = O_PP + (size_t)NBP * 15 * 512,
                 O_KS = O_CP + (size_t)NBP * 2 * UPW, O_VS = O_KS + (size_t)MS * 512, O_PS = O_VS + (size_t)MS * 512, O_CS = O_PS + (size_t)NBS * 15 * 512, O_END = O_CS + (size_t)NBS * 2 * UPW;
static_assert(O_END == 38227968, "output size");
constexpr size_t MiB = 1u << 20;
constexpr size_t WS_CTL = 0, CTL_ZERO_BYTES = 1 * MiB;
constexpr size_t WS_MOD = 1 * MiB, WS_WIN = 5 * MiB, WS_WOUT = 9 * MiB, WS_WUP = 11 * MiB, WS_WDN = 22 * MiB, WS_WPOOL = 28 * MiB;
constexpr size_t WS_XN = 32 * MiB, WS_Z = 66 * MiB, WS_OB = 134 * MiB, WS_MIX = 166 * MiB, WS_MO = 200 * MiB, WS_U = 234 * MiB, WS_ACT = 421 * MiB, WS_F = 515 * MiB, WS_END = 549 * MiB;
static_assert(WS_MOD + (size_t)NMOD * MODW * 4 <= WS_WIN && WS_WUP + (size_t)UPW * D * 2 <= WS_WDN && WS_WDN + (size_t)D * FF * 2 <= WS_WPOOL, "ws map 1");
static_assert(WS_XN + (size_t)M * D * 2 <= WS_Z && WS_Z + (size_t)M * PROJ * 2 <= WS_OB && WS_OB + (size_t)MP * D * 2 <= WS_MIX && WS_MIX + (size_t)M * D * 2 <= WS_MO && WS_MO + (size_t)M * D * 2 <= WS_U, "ws map 2");
static_assert(WS_U + (size_t)M * UPW * 2 <= WS_ACT && WS_ACT + (size_t)M * FF * 2 <= WS_F && WS_F + (size_t)M * D * 2 <= WS_END, "ws map 3");
constexpr int CW_BAR = 4096;
constexpr int RING_BYTES = 131072, LDSCTL_OFF = RING_BYTES, MISC_OFF = LDSCTL_OFF + 320, LDS_BYTES = 147456;
constexpr int RT_OFF = 98304, RT_N = 704, BT_OFF = RT_OFF + 4 * RT_N * 4;
static_assert(BT_OFF + 4 * 128 * 4 <= RING_BYTES, "bias tables inside the ring region");
constexpr int NWAVES = 8;

#include <hip/hip_bf16.h>
#include <cmath>
namespace attn_body {
using bf16=__hip_bfloat16;
using bf16x8=__attribute__((ext_vector_type(8)))short;
using s16x4=__attribute__((ext_vector_type(4)))short;
using f32x16=__attribute__((ext_vector_type(16)))float;
using u32x4=__attribute__((ext_vector_type(4)))unsigned;
constexpr int SEQ=2048,D=64,ZP=2048,OP=1024;
constexpr int NW=8,QBLK=32,QB=QBLK*NW,KVBLK=64,NQB=SEQ/QB;
constexpr int ATTN_UNIT_ROWS=QB;
__device__ __forceinline__ int crow(int r,int hi){return (r&3)+8*(r>>2)+4*hi;}
#define SBAR() __builtin_amdgcn_sched_barrier(0)
typedef __attribute__((address_space(3))) const float* lds_cfptr;
__device__ __forceinline__ void cmask(f32x16&p0,f32x16&p1,int jb,int qrel,int hi,lds_cfptr rtab){
  const float NEG=-INFINITY; int kb=64*jb+4*hi;
  lds_cfptr rp=rtab+(447-qrel+kb);
  #pragma unroll
  for(int r=0;r<16;++r){const int kvl=(r&3)+8*(r>>2); p0[r]+=rp[kvl]; p1[r]+=rp[kvl+32];}
  if(jb>=0){
  #pragma unroll
  for(int r=0;r<16;++r){int kv=kb+(r&3)+8*(r>>2); if(kv>qrel)p0[r]=NEG; if(kv+32>qrel)p1[r]=NEG;}
  }
}

constexpr int NSLOT=3, SLOTB=8192;
constexpr int LDS_K=0, LDS_V=NSLOT*SLOTB, LDS_WS=2*NSLOT*SLOTB, LDS_OST=LDS_WS+NW*64*4, LDS_BYTES=LDS_OST+NW*4096;
constexpr float C2=0.125f*1.4426950408889634f;
__device__ __forceinline__ void glds16(const void*gsrc,unsigned lds_dst){unsigned keep;
  asm volatile("s_mov_b32 %0, m0\n\ts_mov_b32 m0, %2\n\ts_nop 0\n\tglobal_load_lds_dwordx4 %1, off\n\ts_mov_b32 m0, %0":"=&s"(keep):"v"(gsrc),"s"(lds_dst):"memory");}
__device__ __forceinline__ float max3f(float a,float b,float c){float r;asm("v_max3_f32 %0, %1, %2, %3":"=v"(r):"v"(a),"v"(b),"v"(c));return r;}
__device__ __forceinline__ float max2f(float a,float b){float r;asm("v_max_f32_e32 %0, %1, %2":"=v"(r):"v"(a),"v"(b));return r;}
__device__ __forceinline__ float fadd_s(float a,float b){float r;asm("v_add_f32_e32 %0, %1, %2":"=v"(r):"v"(a),"v"(b));return r;}
__device__ __forceinline__ float fsub_s(float a,float b){float r;asm("v_sub_f32_e32 %0, %1, %2":"=v"(r):"v"(a),"v"(b));return r;}
typedef float f32x2_t __attribute__((ext_vector_type(2))); typedef __bf16 bf16x2_t __attribute__((ext_vector_type(2)));
__device__ __forceinline__ unsigned cvtpk_s(float lo,float hi){f32x2_t v={lo,hi};bf16x2_t b=__builtin_convertvector(v,bf16x2_t);return __builtin_bit_cast(unsigned,b);}
#define WAIT_BAR(N) asm volatile("s_waitcnt vmcnt(" #N ") lgkmcnt(0)\n\ts_barrier":::"memory")

__device__ __forceinline__ void qkt(f32x16&p0,f32x16&p1,const char*Kslot,const bf16x8*qr,int r32,int hi){
  const char*kb=Kslot+hi*1024+r32*16;
  #pragma unroll
  for(int d0=0;d0<4;++d0){
    const bf16x8 b0=*reinterpret_cast<const bf16x8*>(kb+d0*2048);
    const bf16x8 b1=*reinterpret_cast<const bf16x8*>(kb+d0*2048+512);
    if(d0==0){p0=__builtin_amdgcn_mfma_f32_32x32x16_bf16(b0,qr[0],f32x16{},0,0,0);p1=__builtin_amdgcn_mfma_f32_32x32x16_bf16(b1,qr[0],f32x16{},0,0,0);}
    else{p0=__builtin_amdgcn_mfma_f32_32x32x16_bf16(b0,qr[d0],p0,0,0,0);p1=__builtin_amdgcn_mfma_f32_32x32x16_bf16(b1,qr[d0],p1,0,0,0);}}
}
typedef __attribute__((address_space(3))) const char* lds_cptr;
typedef short v4i16_t __attribute__((ext_vector_type(4)));
__device__ __forceinline__ void kload8(bf16x8*kf,lds_cptr kp){
  kf[0]=*(const __attribute__((address_space(3))) bf16x8*)(kp);      kf[1]=*(const __attribute__((address_space(3))) bf16x8*)(kp+512);
  kf[2]=*(const __attribute__((address_space(3))) bf16x8*)(kp+2048); kf[3]=*(const __attribute__((address_space(3))) bf16x8*)(kp+2560);
  kf[4]=*(const __attribute__((address_space(3))) bf16x8*)(kp+4096); kf[5]=*(const __attribute__((address_space(3))) bf16x8*)(kp+4608);
  kf[6]=*(const __attribute__((address_space(3))) bf16x8*)(kp+6144); kf[7]=*(const __attribute__((address_space(3))) bf16x8*)(kp+6656);
}
__device__ __forceinline__ void kload2(bf16x8*kf,lds_cptr kp,int j){ kf[2*j]=*(const __attribute__((address_space(3))) bf16x8*)(kp+j*2048); kf[2*j+1]=*(const __attribute__((address_space(3))) bf16x8*)(kp+j*2048+512); }
__device__ __forceinline__ s16x4 vtr(lds_cptr p){ return __builtin_bit_cast(s16x4,__builtin_amdgcn_ds_read_tr16_b64_v4i16((__attribute__((address_space(3))) v4i16_t*)p)); }
__device__ __forceinline__ float rowmax(const f32x16&p0,const f32x16&p1){
  float a=max3f(p0[0],p0[1],p1[0]),b=max3f(p0[2],p0[3],p1[1]);a=max3f(a,p1[2],p1[3]);
  #pragma unroll
  for(int r=4;r<16;r+=4){a=max3f(a,p0[r],p0[r+1]);b=max3f(b,p0[r+2],p0[r+3]);a=max3f(a,p1[r],p1[r+1]);b=max3f(b,p1[r+2],p1[r+3]);}
  const float m=max2f(a,b);
  auto rr=__builtin_amdgcn_permlane32_swap(__float_as_uint(m),__float_as_uint(m),false,false);
  return max2f(__uint_as_float(rr[0]),__uint_as_float(rr[1]));
}
__device__ __forceinline__ void pv(f32x16*o,int vb,bf16x8 pa0,bf16x8 pa1,bf16x8 pa2,bf16x8 pa3){
  #pragma unroll
  for(int d0=0;d0<2;++d0){s16x4 lo[4],hi[4];
    #pragma unroll
    for(int ks=0;ks<4;++ks){
      asm volatile("ds_read_b64_tr_b16 %0,%1 offset:%c2":"=&v"(lo[ks]):"v"(vb),"i"(d0*4096+ks*1024):"memory");
      asm volatile("ds_read_b64_tr_b16 %0,%1 offset:%c2":"=&v"(hi[ks]):"v"(vb),"i"(d0*4096+ks*1024+512):"memory");}
    asm volatile("s_waitcnt lgkmcnt(0)":::"memory");SBAR();
    #define PK(k) (bf16x8){lo[k][0],lo[k][1],lo[k][2],lo[k][3],hi[k][0],hi[k][1],hi[k][2],hi[k][3]}
    o[d0]=__builtin_amdgcn_mfma_f32_32x32x16_bf16(pa0,PK(0),o[d0],0,0,0);
    o[d0]=__builtin_amdgcn_mfma_f32_32x32x16_bf16(pa1,PK(1),o[d0],0,0,0);
    o[d0]=__builtin_amdgcn_mfma_f32_32x32x16_bf16(pa2,PK(2),o[d0],0,0,0);
    o[d0]=__builtin_amdgcn_mfma_f32_32x32x16_bf16(pa3,PK(3),o[d0],0,0,0);
    #undef PK
  }
}

#ifndef ATTN_STORE16
#define ATTN_STORE16(p,v) (*(u32x4*)(p)=(v))
#endif
template<int THRL> __device__ __forceinline__ void attn_unit(long rowbase,int qcol,int kcol,int vcol,int ocol,int qb,const bf16*__restrict__ Z,bf16*O,char*shm,lds_cfptr rtab){
  int tid_=threadIdx.x; asm volatile("":"+v"(tid_));
  const int tid=tid_,lane=tid&63,r32=lane&31,hi=lane>>5; const int wid=__builtin_amdgcn_readfirstlane(tid>>6);
  const int q0=qb*QB;
  const bf16*Qw=Z+(rowbase+q0+wid*QBLK)*ZP+qcol;
  const bf16*Kh=Z+rowbase*ZP+kcol,*Vh=Z+rowbase*ZP+vcol;
  const unsigned lds0=(unsigned)(uintptr_t)shm;
  float*wsf=(float*)(shm+LDS_WS)+wid*64;
  const bf16*ksrc=Kh+(long)lane*ZP+wid*8;
  const bf16*vsrc=Vh+(long)(16*(wid&3)+(lane>>2))*ZP+(wid>>2)*32+(lane&3)*8;
  const unsigned kdst=lds0+LDS_K+wid*1024, vdst=lds0+LDS_V+wid*1024;
  #define DMA_K(t,slot) glds16(ksrc+(long)(t)*KVBLK*ZP,(unsigned)__builtin_amdgcn_readfirstlane(kdst+(slot)))
  #define DMA_V(t,slot) glds16(vsrc+(long)(t)*KVBLK*ZP,(unsigned)__builtin_amdgcn_readfirstlane(vdst+(slot)))
  const int vb0=(int)(lds0+LDS_V)+((lane>>4)&1)*32+(lane&3)*8+(4*hi+((lane&15)>>2))*64;
  const char*Kbase=shm+LDS_K; bf16x8 kf[8];
  const lds_cptr shm3=(lds_cptr)shm; const lds_cptr kp0=shm3+LDS_K+hi*1024+r32*16; const lds_cptr vp0=shm3+LDS_V+((lane>>4)&1)*32+(lane&3)*8+(4*hi+((lane&15)>>2))*64;
  const int NT=(q0+QB)/KVBLK;
  DMA_K(0,0);DMA_V(0,0);DMA_K(1,SLOTB);
  bf16x8 qr[4];
  #pragma unroll
  for(int d0=0;d0<4;++d0)qr[d0]=*reinterpret_cast<const bf16x8*>(&Qw[(long)r32*ZP+d0*16+hi*8]);
  float mhat=0.f,l_reg=0.f;f32x16 o[2];o[0]=f32x16{};o[1]=f32x16{};
  const int qrel=wid*QBLK+r32;
  #define CMASK(P0,P1,t) do{int jb_=(t)-(NT-4); if(jb_>=-3)cmask(P0,P1,jb_,qrel,hi,rtab);}while(0)
  bool resc=false;
  #define START(P0,P1) do{ const float rm=rowmax(P0,P1); resc=false; mhat=rm; \
    _Pragma("unroll") for(int r=0;r<16;++r)P0[r]=__builtin_amdgcn_exp2f(fsub_s(P0[r],mhat)); }while(0)
  #define RESC() do{ if(resc){ asm volatile("s_waitcnt lgkmcnt(0)":::"memory"); \
      _Pragma("unroll") for(int d_=0;d_<2;++d_) _Pragma("unroll") for(int r=0;r<16;++r)o[d_][r]*=wsf[crow(r,hi)]; } }while(0)
  f32x16 pA0,pA1,pB0,pB1;
  int sl_prev=0,sl_cur=0,sl_next=SLOTB;
  #define ROT() do{sl_prev=sl_cur;sl_cur=sl_next;sl_next=(sl_next==(NSLOT-1)*SLOTB)?0:sl_next+SLOTB;}while(0)
  DMA_K(2,2*SLOTB);
  WAIT_BAR(3);
  qkt(pA0,pA1,Kbase,qr,r32,hi);asm volatile("s_nop 15\n\ts_nop 7":"+v"(pA0),"+v"(pA1));CMASK(pA0,pA1,0);
  START(pA0,pA1);
  _Pragma("unroll") for(int r=0;r<16;++r)pA1[r]=__builtin_amdgcn_exp2f(pA1[r]-mhat);
  WAIT_BAR(0);
  DMA_K(3,0);DMA_V(1,SLOTB);
  ROT();
  kload8(kf,kp0+sl_cur);
  WAIT_BAR(2);
  s16x4 vlo[8],vhi[8]; u32x4 pw0,pw1,pw2,pw3;
  #define PKW(P,B) cvtpk_s(P[B],P[B+1])
  #define PAF(k) __builtin_bit_cast(bf16x8,pw##k)
  #define VFR(i) (bf16x8){vlo[i][0],vlo[i][1],vlo[i][2],vlo[i][3],vhi[i][0],vhi[i][1],vhi[i][2],vhi[i][3]}
  #define PIN(x) asm volatile("":"+v"(x))
  #define MX3(a,b,c) __builtin_fmaxf(__builtin_fmaxf((a),(b)),(c))
  #define GAPA(MF,A0,A1,A2,A3,W0,W1,PW) do{ MF; sacc+=A0; sacc+=A1; sacc+=A2; sacc+=A3; PIN(sacc); W0; W1; PIN(PW); SBAR(); }while(0)
  #define EX(v) __builtin_amdgcn_exp2f(v)
  #define GAPB(MF,X,B) do{ MF; X[B]=EX(X[B]-mhat); X[B+1]=EX(X[B+1]-mhat); X[B+2]=EX(X[B+2]-mhat); X[B+3]=EX(X[B+3]-mhat); PIN(X); SBAR(); }while(0)
  #define VRD(i) do{ vlo[i]=vtr(vp_+(((i)>>2)*4096+((i)&3)*1024)); vhi[i]=vtr(vp_+(((i)>>2)*4096+((i)&3)*1024+512)); }while(0)
  #define KRD(G,j) do{ if(G){ kload2(kf,kp0+sl_next,j); SBAR(); } }while(0)
  #define STEP(C0,C1,P0,P1,t,GK,GV,GL) do{ SBAR(); \
    const lds_cptr vp_=vp0+sl_prev; \
    VRD(0); SBAR(); float sacc=(P0[0]+P0[1]); \
    GAPA(C0=__builtin_amdgcn_mfma_f32_32x32x16_bf16(kf[0],qr[0],f32x16{},0,0,0), P0[2],P0[3],P0[4],P0[5],     pw0[0]=PKW(P0,0), pw0[1]=PKW(P0,2), pw0); \
    VRD(4); SBAR(); GAPA(C1=__builtin_amdgcn_mfma_f32_32x32x16_bf16(kf[1],qr[0],f32x16{},0,0,0), P0[6],P0[7],P0[8],P0[9],     pw0[2]=PKW(P0,4), pw0[3]=PKW(P0,6), pw0); \
    VRD(1); SBAR(); GAPA(C0=__builtin_amdgcn_mfma_f32_32x32x16_bf16(kf[2],qr[1],C0,0,0,0),   P0[10],P0[11],P0[12],P0[13], pw1[0]=PKW(P0,8), pw1[1]=PKW(P0,10), pw1); \
    VRD(5); SBAR(); GAPA(C1=__builtin_amdgcn_mfma_f32_32x32x16_bf16(kf[3],qr[1],C1,0,0,0),   P0[14],P0[15],P1[0],P1[1],   pw1[2]=PKW(P0,12),pw1[3]=PKW(P0,14), pw1); \
    VRD(2); SBAR(); GAPA(C0=__builtin_amdgcn_mfma_f32_32x32x16_bf16(kf[4],qr[2],C0,0,0,0),   P1[2],P1[3],P1[4],P1[5],     pw2[0]=PKW(P1,0), pw2[1]=PKW(P1,2), pw2); \
    VRD(6); SBAR(); GAPA(C1=__builtin_amdgcn_mfma_f32_32x32x16_bf16(kf[5],qr[2],C1,0,0,0),   P1[6],P1[7],P1[8],P1[9],     pw2[2]=PKW(P1,4), pw2[3]=PKW(P1,6), pw2); \
    VRD(3); SBAR(); GAPA(C0=__builtin_amdgcn_mfma_f32_32x32x16_bf16(kf[6],qr[3],C0,0,0,0),   P1[10],P1[11],P1[12],P1[13], pw3[0]=PKW(P1,8), pw3[1]=PKW(P1,10), pw3); \
    VRD(7); SBAR(); GAPA(C1=__builtin_amdgcn_mfma_f32_32x32x16_bf16(kf[7],qr[3],C1,0,0,0),   P1[14],P1[15],0.f,0.f,       pw3[2]=PKW(P1,12),pw3[3]=PKW(P1,14), pw3); \
    l_reg+=sacc; \
    if(GK){DMA_K((t)+3,sl_cur);} if(GV){DMA_V((t)+1,sl_next);} \
    CMASK(C0,C1,t); \
    { float a=MX3(C0[0],C0[1],C1[0]),b=MX3(C0[2],C0[3],C1[1]); a=MX3(a,C1[2],C1[3]); \
      _Pragma("unroll") for(int r=4;r<16;r+=4){a=MX3(a,C0[r],C0[r+1]);b=MX3(b,C0[r+2],C0[r+3]);a=MX3(a,C1[r],C1[r+1]);b=MX3(b,C1[r+2],C1[r+3]);} \
      float rm=__builtin_fmaxf(a,b); { auto rr=__builtin_amdgcn_permlane32_swap(__float_as_uint(rm),__float_as_uint(rm),false,false); rm=__builtin_fmaxf(__uint_as_float(rr[0]),__uint_as_float(rr[1])); } \
      resc=false; rm-=mhat; \
      if(__builtin_expect(__any(rm>(float)THRL),0)){ const float dl=__builtin_fmaxf(rm,0.f); mhat+=dl; \
        const float f=__builtin_amdgcn_exp2f(-dl); l_reg*=f; if(hi==0)wsf[r32]=f; resc=true; } } \
    SBAR(); \
    GAPB(o[0]=__builtin_amdgcn_mfma_f32_32x32x16_bf16(PAF(0),VFR(0),o[0],0,0,0), C0,0); \
    GAPB(o[1]=__builtin_amdgcn_mfma_f32_32x32x16_bf16(PAF(0),VFR(4),o[1],0,0,0), C0,4); \
    KRD(GL,0); GAPB(o[0]=__builtin_amdgcn_mfma_f32_32x32x16_bf16(PAF(1),VFR(1),o[0],0,0,0), C0,8); \
    KRD(GL,1); GAPB(o[1]=__builtin_amdgcn_mfma_f32_32x32x16_bf16(PAF(1),VFR(5),o[1],0,0,0), C0,12); \
    KRD(GL,2); GAPB(o[0]=__builtin_amdgcn_mfma_f32_32x32x16_bf16(PAF(2),VFR(2),o[0],0,0,0), C1,0); \
    KRD(GL,3); GAPB(o[1]=__builtin_amdgcn_mfma_f32_32x32x16_bf16(PAF(2),VFR(6),o[1],0,0,0), C1,4); \
    GAPB(o[0]=__builtin_amdgcn_mfma_f32_32x32x16_bf16(PAF(3),VFR(3),o[0],0,0,0), C1,8); \
    GAPB(o[1]=__builtin_amdgcn_mfma_f32_32x32x16_bf16(PAF(3),VFR(7),o[1],0,0,0), C1,12); \
    }while(0)
  int t=1;
  #undef CMASK
  #define CMASK(P0,P1,t) do{}while(0)
  for(;t+7<NT;t+=2){
    STEP(pB0,pB1,pA0,pA1,t,true,true,true);     WAIT_BAR(2); RESC(); ROT();
    STEP(pA0,pA1,pB0,pB1,t+1,true,true,true);   WAIT_BAR(2); RESC(); ROT();
  }
  #undef CMASK
  #define CMASK(P0,P1,t) do{int jb_=(t)-(NT-4); if(jb_>=-3)cmask(P0,P1,jb_,qrel,hi,rtab);}while(0)
  #define ENDW(tt) do{ if((tt)+3<NT){WAIT_BAR(2);} else if((tt)+2<NT){WAIT_BAR(1);} else {WAIT_BAR(0);} }while(0)
  for(;t+1<NT;t+=2){
    STEP(pB0,pB1,pA0,pA1,t,(t+3<NT),(t+1<NT),(t+1<NT));       ENDW(t);   RESC(); ROT();
    STEP(pA0,pA1,pB0,pB1,t+1,(t+4<NT),(t+2<NT),(t+2<NT));     ENDW(t+1); RESC(); ROT();
  }
  STEP(pB0,pB1,pA0,pA1,NT-1,false,false,false); RESC();
  { float sacc=pB0[0]+pB0[1]; _Pragma("unroll") for(int r=2;r<16;++r)sacc+=pB0[r]; _Pragma("unroll") for(int r=0;r<16;++r)sacc+=pB1[r]; l_reg+=sacc;
    pw0=(u32x4){PKW(pB0,0),PKW(pB0,2),PKW(pB0,4),PKW(pB0,6)};pw1=(u32x4){PKW(pB0,8),PKW(pB0,10),PKW(pB0,12),PKW(pB0,14)};pw2=(u32x4){PKW(pB1,0),PKW(pB1,2),PKW(pB1,4),PKW(pB1,6)};pw3=(u32x4){PKW(pB1,8),PKW(pB1,10),PKW(pB1,12),PKW(pB1,14)};
    SBAR(); pv(o,vb0+sl_cur,PAF(0),PAF(1),PAF(2),PAF(3)); }
  #undef PKW
  #undef PAF
  #undef VFR
  #undef PIN
  #undef MX3
  #undef GAPA
  #undef GAPB
  #undef EX
  #undef VRD
  #undef KRD
  #undef STEP
  #undef ENDW
  {auto rr=__builtin_amdgcn_permlane32_swap(__float_as_uint(l_reg),__float_as_uint(l_reg),false,false);l_reg=__uint_as_float(rr[0])+__uint_as_float(rr[1]);}
  if(hi==0)wsf[32+r32]=l_reg;asm volatile("s_waitcnt lgkmcnt(0)":::"memory");
  float rli[16];
  #pragma unroll
  for(int r=0;r<16;++r)rli[r]=__builtin_amdgcn_rcpf(wsf[32+crow(r,hi)]);
  bf16*Ow=O+(rowbase+q0+wid*QBLK)*OP+ocol;
  { bf16*stg=(bf16*)(shm+LDS_OST)+wid*2048;
    #pragma unroll
    for(int r=0;r<16;++r){const int orow=crow(r,hi);
      #pragma unroll
      for(int d0=0;d0<2;++d0)stg[orow*64+d0*32+r32]=__float2bfloat16(o[d0][r]*rli[r]);}
    asm volatile("s_waitcnt lgkmcnt(0)":::"memory");
    #pragma unroll
    for(int i=0;i<4;++i){const int row=i*8+(lane>>3),ch=lane&7; const u32x4 v=*(const u32x4*)(stg+row*64+ch*8); ATTN_STORE16(Ow+(long)row*OP+ch*8,v);} }
  asm volatile("s_waitcnt lgkmcnt(0)\n\ts_barrier":::"memory");
  #undef DMA_K
  #undef DMA_V
  #undef CMASK
  #undef START
  #undef RESC
  #undef ROT
}
constexpr int ATTN_LDS_BYTES=LDS_BYTES;
#undef SBAR
#undef WAIT_BAR
}
#define GAS __attribute__((address_space(1)))
#define LAS __attribute__((address_space(3)))
typedef unsigned short bf16;
typedef unsigned v4u __attribute__((ext_vector_type(4)));
typedef float f32x4 __attribute__((ext_vector_type(4)));
typedef short bf16x8 __attribute__((ext_vector_type(8)));
typedef GAS unsigned gu32;
typedef GAS unsigned long long gu64;
#define RLX_AGENT __ATOMIC_RELAXED, __HIP_MEMORY_SCOPE_AGENT
#define LDS_WAIT() asm volatile("s_waitcnt lgkmcnt(0)" ::: "memory")
#define VM_WAIT() asm volatile("s_waitcnt vmcnt(0)" ::: "memory")
__device__ __forceinline__ unsigned long long rt() { return __builtin_amdgcn_s_memrealtime(); }
__device__ __forceinline__ unsigned f2bf(float f) { unsigned u = __builtin_bit_cast(unsigned, f); return (u + 0x7fffu + ((u >> 16) & 1u)) >> 16; }
__device__ __forceinline__ unsigned pk2(float lo, float hi) { return f2bf(lo) | (f2bf(hi) << 16); }
#define XB_TMO      128
#define XB_XCNT(j)  (256  + 64 * (j))
#define XB_XSUB(j)  (1280 + 64 * (j))
#define XB_XGEN(j)  (2304 + 64 * (j))
#define XB_TOP      3328
#define XB_TOPGEN   3392
#define XCD_BAR_WORDS 3456
#define XB_SPIN_CAP (1u << 18)

__device__ __forceinline__ unsigned xb_ld(unsigned* p)              { return __hip_atomic_load(p, __ATOMIC_RELAXED, __HIP_MEMORY_SCOPE_AGENT); }
__device__ __forceinline__ unsigned xb_add(unsigned* p, unsigned v) { return __hip_atomic_fetch_add(p, v, __ATOMIC_RELAXED, __HIP_MEMORY_SCOPE_AGENT); }
__device__ __forceinline__ unsigned xb_xcc_id() { return (unsigned)__builtin_amdgcn_s_getreg((3 << 11) | 20) & 0xFu; }
#define XB_SPIN(cond, bar) do { unsigned _sp = 0; while (cond) { __builtin_amdgcn_s_sleep(1); \
    if ((++_sp & 255u) == 0u) { if (xb_ld(&(bar)[XB_TMO])) break; if (_sp > XB_SPIN_CAP) { atomicAdd(&(bar)[XB_TMO], 1u); break; } } } } while (0)

struct XcdBarrier {
    unsigned* bar; unsigned x;
    volatile LAS unsigned* st;
};

__device__ __forceinline__ XcdBarrier xcd_barrier_post(unsigned* bar, volatile LAS unsigned* st) {
    XcdBarrier b; b.bar = bar; b.x = xb_xcc_id(); b.st = st;
    if (threadIdx.x == 0) (void)xb_add(&bar[XB_XCNT(b.x)], 1u);
    return b;
}
__device__ __forceinline__ void xcd_barrier_complete(unsigned* bar, unsigned x, unsigned& nloc, unsigned& nx) {
    const unsigned G = gridDim.x * gridDim.y * gridDim.z;
    unsigned sum, cnt, mine, sp = 0u;
    for (;;) {
        sum = 0u; cnt = 0u; mine = 0u;
#pragma unroll
        for (unsigned j = 0; j < 16; ++j) { const unsigned c = xb_ld(&bar[XB_XCNT(j)]); sum += c; cnt += (c > 0u) ? 1u : 0u; mine = (j == x) ? c : mine; }
        if (sum == G) break;
        __builtin_amdgcn_s_sleep(1);
        if ((++sp & 255u) == 0u) { if (xb_ld(&bar[XB_TMO])) break; if (sp > XB_SPIN_CAP) { atomicAdd(&bar[XB_TMO], 1u); break; } }
    }
    nloc = mine > 0u ? mine : 1u; nx = cnt > 0u ? cnt : 1u;
}

__device__ __forceinline__ void xcd_barrier(const XcdBarrier& b) {
    asm volatile("s_waitcnt vmcnt(0)" ::: "memory");
    __syncthreads();
    if (threadIdx.x == 0) {
        unsigned* bar = b.bar;
        __builtin_amdgcn_s_waitcnt(0);
        unsigned nloc = b.st[0], nx = b.st[1];
        if (nloc == 0u) { xcd_barrier_complete(bar, b.x, nloc, nx); b.st[0] = nloc; b.st[1] = nx; }
        const unsigned old = xb_add(&bar[XB_XSUB(b.x)], 1u);
        const unsigned gen = old / nloc;
        if (old + 1u == (gen + 1u) * nloc) {
            __builtin_amdgcn_fence(__ATOMIC_RELEASE, "agent");
            asm volatile("s_waitcnt vmcnt(0)" ::: "memory");
            const unsigned og = xb_add(&bar[XB_TOP], 1u);
            const unsigned tg = og / nx;
            if (og + 1u == (tg + 1u) * nx) xb_add(&bar[XB_TOPGEN], 1u);
            else XB_SPIN(xb_ld(&bar[XB_TOPGEN]) == tg, bar);
            __builtin_amdgcn_fence(__ATOMIC_ACQUIRE, "agent");
            xb_add(&bar[XB_XGEN(b.x)], 1u);
            asm volatile("s_waitcnt vmcnt(0)" ::: "memory");
        } else {
            XB_SPIN(xb_ld(&bar[XB_XGEN(b.x)]) == gen, bar);
            __builtin_amdgcn_fence(__ATOMIC_ACQUIRE, "agent");
            asm volatile("s_waitcnt vmcnt(0)" ::: "memory");
        }
    }
    __syncthreads();
}

typedef unsigned v2u __attribute__((ext_vector_type(2)));
typedef float f32x2 __attribute__((ext_vector_type(2)));
typedef __bf16 bf16x2v __attribute__((ext_vector_type(2)));
__device__ __forceinline__ unsigned pkbf(float lo, float hi) { f32x2 v = {lo, hi}; bf16x2v b = __builtin_convertvector(v, bf16x2v); return __builtin_bit_cast(unsigned, b); }
__device__ __forceinline__ float bflo(unsigned w) { return __builtin_bit_cast(float, w << 16); }
__device__ __forceinline__ float bfhi(unsigned w) { return __builtin_bit_cast(float, w & 0xffff0000u); }
__device__ __forceinline__ float wave_sum(float v) {
#pragma unroll
    for (int o = 1; o < 64; o <<= 1) v += __shfl_xor(v, o);
    return v;
}
__device__ __forceinline__ bf16x8 pack8(f32x4 a, f32x4 b) { v4u w; w.x = pkbf(a[0], a[1]); w.y = pkbf(a[2], a[3]); w.z = pkbf(b[0], b[1]); w.w = pkbf(b[2], b[3]); return __builtin_bit_cast(bf16x8, w); }
#define MFMA16(a, b, c) __builtin_amdgcn_mfma_f32_16x16x32_bf16((a), (b), (c), 0, 0, 0)

struct Args { const float* in[29]; float* out; unsigned char* ws; int ph_lo, ph_hi; };
static_assert(sizeof(Args) == 256, "Args has no padding");
enum { I_XP = 0, I_XS, I_CP, I_CS, I_CK, I_CV, I_PT, I_SP, I_SC, I_WADA, I_BADA, I_GPM, I_GQM, I_GPF, I_GQF, I_WIN, I_WOUT, I_WPOOL, I_PSCALE,
       I_LQ1, I_LK1, I_LQ2, I_LK2, I_GHEAD, I_RELB, I_WUP, I_CONVW, I_CONVB, I_WDN };

struct EpiZ {
    static constexpr bool PERM = true, AFTER_DRAIN = false;
    bf16* Z; float* out;
    __device__ __forceinline__ void operator()(const pg8::f32x4 (&acc)[2][2][4][2], const pg8::Unit& u, int wr, int wc, int fr, int fq) const {
        const int region = u.pn >> 1;
        const float sc = region == 1 ? QSCALE : 1.f;
        const int rowt = u.pm * 256 + wr * 64 + fr, colt = u.pn * 256 + wc * 32 + 8 * fq, colr = colt - region * 512;
#pragma unroll
        for (int ai = 0; ai < 2; ++ai)
#pragma unroll
            for (int m = 0; m < 4; ++m) {
                const int row = rowt + ai * 128 + m * 16;
                bf16* zp = Z + (size_t)row * PROJ + colt;
#pragma unroll
                for (int bj = 0; bj < 2; ++bj) { const pg8::f32x4 v0 = acc[ai][bj][m][0] * sc, v1 = acc[ai][bj][m][1] * sc;
                    v4u w; w.x = pkbf(v0[0], v0[1]); w.y = pkbf(v0[2], v0[3]); w.z = pkbf(v1[0], v1[1]); w.w = pkbf(v1[2], v1[3]); *(v4u*)(zp + bj * 128) = w; }
                float* op = nullptr;
                if (region >= 2) {
                    op = (row < MP) ? out + (region == 2 ? O_KP : O_VP) + (size_t)row * 512 : out + (region == 2 ? O_KS : O_VS) + (size_t)(row - MP) * 512;
                } else if (region == 0) {
                    if (row < MP) { const int t = row & (TP - 1); if (t >= TP - 15) op = out + O_PP + (size_t)((row >> 11) * 15 + (t - (TP - 15))) * 512; }
                    else { const int r = row - MP; op = out + O_PS + (size_t)((r >> 3) * 15 + 7 + (r & 7)) * 512; }
                }
                if (op) {
#pragma unroll
                    for (int bj = 0; bj < 2; ++bj) { *(pg8::f32x4*)(op + colr + bj * 128) = acc[ai][bj][m][0]; *(pg8::f32x4*)(op + colr + bj * 128 + 4) = acc[ai][bj][m][1]; }
                }
            }
    }
};
struct EpiPlain {
    static constexpr bool PERM = true, AFTER_DRAIN = false;
    bf16* O; int ldc;
    __device__ __forceinline__ void operator()(const pg8::f32x4 (&acc)[2][2][4][2], const pg8::Unit& u, int wr, int wc, int fr, int fq) const {
        const int rowt = u.pm * 256 + wr * 64 + fr, colt = u.pn * 256 + wc * 32 + 8 * fq;
#pragma unroll
        for (int ai = 0; ai < 2; ++ai)
#pragma unroll
            for (int m = 0; m < 4; ++m) {
                bf16* zp = O + (size_t)(rowt + ai * 128 + m * 16) * ldc + colt;
#pragma unroll
                for (int bj = 0; bj < 2; ++bj) { const pg8::f32x4 v0 = acc[ai][bj][m][0], v1 = acc[ai][bj][m][1];
                    v4u w; w.x = pkbf(v0[0], v0[1]); w.y = pkbf(v0[2], v0[3]); w.z = pkbf(v1[0], v1[1]); w.w = pkbf(v1[2], v1[3]); *(v4u*)(zp + bj * 128) = w; }
            }
    }
};
struct EpiU {
    static constexpr bool PERM = true, AFTER_DRAIN = false;
    bf16* U; float* out;
    __device__ __forceinline__ void operator()(const pg8::f32x4 (&acc)[2][2][4][2], const pg8::Unit& u, int wr, int wc, int fr, int fq) const {
        const int rowt = u.pm * 256 + wr * 64 + fr, colt = u.pn * 256 + wc * 32 + 8 * fq;
#pragma unroll
        for (int ai = 0; ai < 2; ++ai)
#pragma unroll
            for (int m = 0; m < 4; ++m) {
                const int row = rowt + ai * 128 + m * 16;
                bf16* zp = U + (size_t)row * UPW + colt;
#pragma unroll
                for (int bj = 0; bj < 2; ++bj) { const pg8::f32x4 v0 = acc[ai][bj][m][0], v1 = acc[ai][bj][m][1];
                    v4u w; w.x = pkbf(v0[0], v0[1]); w.y = pkbf(v0[2], v0[3]); w.z = pkbf(v1[0], v1[1]); w.w = pkbf(v1[2], v1[3]); *(v4u*)(zp + bj * 128) = w; }
                float* op = nullptr;
                if (row < MP) { const int t = row & (TP - 1); if (t >= TP - 2) op = out + O_CP + (size_t)((row >> 11) * 2 + (t - (TP - 2))) * UPW; }
                else { const int r = row - MP; if ((r & 7) >= 6) op = out + O_CS + (size_t)((r >> 3) * 2 + ((r & 7) - 6)) * UPW; }
                if (op) {
#pragma unroll
                    for (int bj = 0; bj < 2; ++bj) { *(pg8::f32x4*)(op + colt + bj * 128) = acc[ai][bj][m][0]; *(pg8::f32x4*)(op + colt + bj * 128 + 4) = acc[ai][bj][m][1]; }
                }
            }
    }
};

__device__ __forceinline__ void p0_transpose_item(const float* W, int K, int N, bf16* WT, LAS float* scr, int item, int lane) {
    const int nblk = N / 32, kb = item / nblk, nb = item % nblk, k0 = 64 * kb, n0 = 32 * nb;
#pragma unroll 8
    for (int i = 0; i < 32; ++i) { const int kk = 2 * i + (lane >> 5); scr[kk * 33 + (lane & 31)] = W[(size_t)(k0 + kk) * N + n0 + (lane & 31)]; }
    LDS_WAIT(); asm volatile("" ::: "memory");
    const int c = lane & 7;
#pragma unroll
    for (int j = 0; j < 4; ++j) { const int n = (lane >> 3) + 8 * j; const LAS float* s = scr + (8 * c) * 33 + n;
        v4u o; o.x = pkbf(s[0 * 33], s[1 * 33]); o.y = pkbf(s[2 * 33], s[3 * 33]); o.z = pkbf(s[4 * 33], s[5 * 33]); o.w = pkbf(s[6 * 33], s[7 * 33]);
        *(GAS v4u*)(WT + (size_t)(n0 + n) * K + k0 + 8 * c) = o; }
    LDS_WAIT(); asm volatile("" ::: "memory");
}
__device__ __forceinline__ float silu_f(float x) { return x / (1.f + __expf(-x)); }
__device__ __forceinline__ void p0_mod_slice(const Args& a, LAS unsigned char* lds, int slice, int tid) {
    const int wave = __builtin_amdgcn_readfirstlane(tid >> 6), lane = tid & 63, n = lane & 15, kg = lane >> 4;
    const int kq = wave & 3, mh = wave >> 2, mb0 = mh ? 5 : 0, nmb = mh ? 4 : 5, c0 = slice * 32;
    const float* wada = a.in[I_WADA]; const float* cp = a.in[I_CP]; const float* cs = a.in[I_CS];
    pg8::f32x4 acc[5][2];
#pragma unroll
    for (int i = 0; i < 5; ++i) { acc[i][0] = (pg8::f32x4){0.f, 0.f, 0.f, 0.f}; acc[i][1] = acc[i][0]; }
    for (int ks = 0; ks < 8; ++ks) {
        const int k0 = kq * 256 + ks * 32 + kg * 8;
        bf16x8 bfr[2];
#pragma unroll
        for (int nb = 0; nb < 2; ++nb) { float w[8];
#pragma unroll
            for (int j = 0; j < 8; ++j) w[j] = wada[(size_t)(k0 + j) * MODW + c0 + nb * 16 + n];
            bfr[nb] = pack8((pg8::f32x4){w[0], w[1], w[2], w[3]}, (pg8::f32x4){w[4], w[5], w[6], w[7]}); }
#pragma unroll
        for (int mi = 0; mi < 5; ++mi) {
            if (mi < nmb) {
                const int row = (mb0 + mi) * 16 + n;
                pg8::f32x4 x0 = {0.f, 0.f, 0.f, 0.f}, x1 = x0;
                if (row < NMOD) { const float* cr = (row < NBP ? cp + (size_t)row * D : cs + (size_t)(row - NBP) * D) + k0; x0 = *(const pg8::f32x4*)cr; x1 = *(const pg8::f32x4*)(cr + 4); }
#pragma unroll
                for (int j = 0; j < 4; ++j) { x0[j] = silu_f(x0[j]); x1[j] = silu_f(x1[j]); }
                const bf16x8 af = pack8(x0, x1);
                acc[mi][0] = MFMA16(af, bfr[0], acc[mi][0]); acc[mi][1] = MFMA16(af, bfr[1], acc[mi][1]);
            }
        }
    }
    LAS float* P = (LAS float*)lds;
#pragma unroll
    for (int mi = 0; mi < 5; ++mi) if (mi < nmb) {
#pragma unroll
        for (int nb = 0; nb < 2; ++nb)
#pragma unroll
            for (int i = 0; i < 4; ++i) P[(kq * 144 + (mb0 + mi) * 16 + kg * 4 + i) * 32 + nb * 16 + n] = acc[mi][nb][i];
    }
    __syncthreads();
    float* mod = (float*)(a.ws + WS_MOD); const float* bada = a.in[I_BADA];
    for (int idx = tid; idx < NMOD * 32; idx += NWAVES * 64) { const int row = idx >> 5, col = idx & 31;
        const float v = ((P[(0 * 144 + row) * 32 + col] + P[(1 * 144 + row) * 32 + col]) + (P[(2 * 144 + row) * 32 + col] + P[(3 * 144 + row) * 32 + col])) + bada[c0 + col];
        mod[(size_t)row * MODW + c0 + col] = v; }
    __syncthreads();
}
__device__ __forceinline__ void p0_prologue(const Args& a, LAS unsigned char* lds, int tid, int G) {
    const int wave = __builtin_amdgcn_readfirstlane(tid >> 6), lane = tid & 63;
    for (int s = blockIdx.x; s < MODW / 32; s += G) p0_mod_slice(a, lds, s, tid);
    LAS float* scr = (LAS float*)(lds + wave * 16384);
    const int gw = blockIdx.x * NWAVES + wave, NGW = G * NWAVES;
    constexpr int I_1 = (D / 64) * (PROJ / 32), I_2 = (D / 64) * (D / 32), I_3 = (D / 64) * (UPW / 32), I_4 = (FF / 64) * (D / 32), I_5 = 4 * 8;
    constexpr int NITEMS = I_1 + I_2 + I_3 + I_4 + I_5;
    for (int it = (gw + NGW - (MODW / 32) * NWAVES % NGW) % NGW; it < NITEMS; it += NGW) {
        int r = it;
        if (r < I_1) { p0_transpose_item(a.in[I_WIN], D, PROJ, (bf16*)(a.ws + WS_WIN), scr, r, lane); continue; } r -= I_1;
        if (r < I_2) { p0_transpose_item(a.in[I_WOUT], D, D, (bf16*)(a.ws + WS_WOUT), scr, r, lane); continue; } r -= I_2;
        if (r < I_3) { p0_transpose_item(a.in[I_WUP], D, UPW, (bf16*)(a.ws + WS_WUP), scr, r, lane); continue; } r -= I_3;
        if (r < I_4) { p0_transpose_item(a.in[I_WDN], FF, D, (bf16*)(a.ws + WS_WDN), scr, r, lane); continue; } r -= I_4;
        { const int g = r >> 3; p0_transpose_item(a.in[I_WPOOL] + (size_t)g * 16384, 128, 128, (bf16*)(a.ws + WS_WPOOL) + (size_t)g * 16384, scr, r & 7, lane); }
    }
}
__device__ __forceinline__ const float* x_row(const Args& a, int row) { return row < MP ? a.in[I_XP] + (size_t)row * D : a.in[I_XS] + (size_t)(row - MP) * D; }
__device__ __forceinline__ int mod_row(int row) { return row < MP ? (row >> 11) : NBP + ((row - MP) >> 3); }
__device__ __forceinline__ void p1_norm_in(const Args& a, int gw, int NGW, int lane) {
    const float* mod = (const float*)(a.ws + WS_MOD); const float* g = a.in[I_GPM]; bf16* XN = (bf16*)(a.ws + WS_XN);
    for (int row = gw; row < M; row += NGW) {
        const GAS f32x4* xr = (const GAS f32x4*)x_row(a, row) + lane; const float* md = mod + (size_t)mod_row(row) * MODW;
        f32x4 v[4]; float ss = 0.f;
#pragma unroll
        for (int j = 0; j < 4; ++j) { v[j] = xr[64 * j]; ss += (v[j].x * v[j].x + v[j].y * v[j].y) + (v[j].z * v[j].z + v[j].w * v[j].w); }
        const float rstd = 1.f / sqrtf(wave_sum(ss) * (1.f / D) + EPS);
        GAS v2u* o8 = (GAS v2u*)(XN + (size_t)row * D) + lane;
#pragma unroll
        for (int j = 0; j < 4; ++j) { const int col = 4 * lane + 256 * j;
            const f32x4 gg = *(const f32x4*)(g + col), sh = *(const f32x4*)(md + col), sc = *(const f32x4*)(md + D + col);
            const f32x4 h = v[j] * rstd * gg * (sc + 1.f) + sh;
            v2u w; w.x = pkbf(h.x, h.y); w.y = pkbf(h.z, h.w); o8[64 * j] = w; }
    }
}
__device__ __forceinline__ void p6_norm_mid(const Args& a, int gw, int NGW, int lane) {
    const float* mod = (const float*)(a.ws + WS_MOD); const float* gq = a.in[I_GQM]; const float* gp = a.in[I_GPF];
    const bf16* MO = (const bf16*)(a.ws + WS_MO); bf16* XN = (bf16*)(a.ws + WS_XN);
    for (int row = gw; row < M; row += NGW) {
        const GAS f32x4* xr = (const GAS f32x4*)x_row(a, row) + lane; const float* md = mod + (size_t)mod_row(row) * MODW;
        const GAS v2u* mr = (const GAS v2u*)(MO + (size_t)row * D) + lane;
        f32x4 v[4], mm[4]; float ss = 0.f;
#pragma unroll
        for (int j = 0; j < 4; ++j) { v[j] = xr[64 * j]; const v2u w = mr[64 * j]; mm[j] = (f32x4){bflo(w.x), bfhi(w.x), bflo(w.y), bfhi(w.y)};
            ss += (mm[j].x * mm[j].x + mm[j].y * mm[j].y) + (mm[j].z * mm[j].z + mm[j].w * mm[j].w); }
        const float rstd = 1.f / sqrtf(wave_sum(ss) * (1.f / D) + EPS);
        float s1 = 0.f;
        GAS f32x4* x1o = (GAS f32x4*)(a.out + O_Y + (size_t)row * D) + lane;
#pragma unroll
        for (int j = 0; j < 4; ++j) { const int col = 4 * lane + 256 * j;
            const f32x4 gg = *(const f32x4*)(gq + col), gt = *(const f32x4*)(md + 2 * D + col);
            v[j] = v[j] + gt * (mm[j] * rstd * gg); x1o[64 * j] = v[j];
            s1 += (v[j].x * v[j].x + v[j].y * v[j].y) + (v[j].z * v[j].z + v[j].w * v[j].w); }
        const float rstd1 = 1.f / sqrtf(wave_sum(s1) * (1.f / D) + EPS);
        GAS v2u* o8 = (GAS v2u*)(XN + (size_t)row * D) + lane;
#pragma unroll
        for (int j = 0; j < 4; ++j) { const int col = 4 * lane + 256 * j;
            const f32x4 gg = *(const f32x4*)(gp + col), sh = *(const f32x4*)(md + 3 * D + col), sc = *(const f32x4*)(md + 4 * D + col);
            const f32x4 h = v[j] * rstd1 * gg * (sc + 1.f) + sh;
            v2u w; w.x = pkbf(h.x, h.y); w.y = pkbf(h.z, h.w); o8[64 * j] = w; }
    }
}
__device__ __forceinline__ void p10_norm_out(const Args& a, int gw, int NGW, int lane) {
    const float* mod = (const float*)(a.ws + WS_MOD); const float* gq = a.in[I_GQF]; const bf16* Fb = (const bf16*)(a.ws + WS_F);
    for (int row = gw; row < M; row += NGW) {
        const float* md = mod + (size_t)mod_row(row) * MODW;
        GAS f32x4* xr = (GAS f32x4*)(a.out + O_Y + (size_t)row * D) + lane; const GAS v2u* fr = (const GAS v2u*)(Fb + (size_t)row * D) + lane;
        f32x4 v[4], mm[4]; float ss = 0.f;
#pragma unroll
        for (int j = 0; j < 4; ++j) { v[j] = xr[64 * j]; const v2u w = fr[64 * j]; mm[j] = (f32x4){bflo(w.x), bfhi(w.x), bflo(w.y), bfhi(w.y)};
            ss += (mm[j].x * mm[j].x + mm[j].y * mm[j].y) + (mm[j].z * mm[j].z + mm[j].w * mm[j].w); }
        const float rstd = 1.f / sqrtf(wave_sum(ss) * (1.f / D) + EPS);
#pragma unroll
        for (int j = 0; j < 4; ++j) { const int col = 4 * lane + 256 * j;
            const f32x4 gg = *(const f32x4*)(gq + col), gt = *(const f32x4*)(md + 5 * D + col);
            xr[64 * j] = v[j] + gt * (mm[j] * rstd * gg); }
    }
}

__device__ __forceinline__ int rel_bucket(int dist) {
    if (dist < 16) return dist;
    int large = 16 + (int)(log((double)dist / 16.0) / log(8.0) * 16.0);
    return large < 31 ? large : 31;
}
__device__ __forceinline__ void build_bias_tables(const Args& a, LAS unsigned char* lds, int tid) {
    LAS float* RT = (LAS float*)(lds + RT_OFF); LAS float* BT = (LAS float*)(lds + BT_OFF); const float* rb = a.in[I_RELB];
    for (int i = tid; i < 4 * 128; i += NWAVES * 64) { const int h = i >> 7, d = i & 127; BT[i] = (rb[rel_bucket(d) * 4 + h] - rb[31 * 4 + h]) * LOG2E; }
    __syncthreads();
    for (int i = tid; i < 4 * RT_N; i += NWAVES * 64) { const int h = i / RT_N, idx = i % RT_N, dist = 447 - idx; RT[i] = (dist >= 0 && dist <= 127) ? BT[h * 128 + dist] : 0.f; }
    __syncthreads();
}
__device__ __forceinline__ float lam_value(const Args& a, int lane) {
    const float p1 = wave_sum(a.in[I_LQ1][lane] * a.in[I_LK1][lane]), p2 = wave_sum(a.in[I_LQ2][lane] * a.in[I_LK2][lane]);
    return expf(p1) - expf(p2) + LAM_INIT;
}
constexpr int SA_OSTR = 132;
__device__ __forceinline__ void sattn_unit(const Args& a, LAS unsigned char* lds, int s, int h, float lam, int tid) {
    const int wave = __builtin_amdgcn_readfirstlane(tid >> 6), lane = tid & 63, n = lane & 15, kg = lane >> 4, qi = n & 7, qc = n >> 3;
    const bf16* Z = (const bf16*)(a.ws + WS_Z); const float* ck = a.in[I_CK]; const float* cv = a.in[I_CV]; const int* pt = (const int*)a.in[I_PT] + s * NPAGES;
    const LAS float* BT = (const LAS float*)(lds + BT_OFF) + h * 128;
    bf16x8 qf[4];
#pragma unroll
    for (int ks = 0; ks < 4; ++ks) { v4u w = {0u, 0u, 0u, 0u};
        if ((ks >> 1) == qc) w = *(const v4u*)(Z + (size_t)(MP + s * TS + qi) * PROJ + 512 + h * 128 + qc * 64 + (ks & 1) * 32 + kg * 8);
        qf[ks] = __builtin_bit_cast(bf16x8, w); }
    pg8::f32x4 o[8];
#pragma unroll
    for (int vb = 0; vb < 8; ++vb) o[vb] = (pg8::f32x4){0.f, 0.f, 0.f, 0.f};
    float mrun = -INFINITY, lrun = 0.f;
    for (int tt = 0; tt < 8; ++tt) {
        const int key0 = wave * 256 + tt * 32, page = pt[key0 >> 7], slot0 = key0 & 127;
        const float* kb = ck + ((size_t)(page * PAGE + slot0) * 4 + h) * 128;
        const float* vbp = cv + ((size_t)(page * PAGE + slot0) * 4 + h) * 128;
        pg8::f32x4 kr[2][4][2]; float vr[8][8];
#pragma unroll
        for (int b2 = 0; b2 < 2; ++b2)
#pragma unroll
            for (int ks = 0; ks < 4; ++ks) { const float* p = kb + (size_t)(b2 * 16 + n) * 512 + ks * 32 + kg * 8; kr[b2][ks][0] = *(const pg8::f32x4*)p; kr[b2][ks][1] = *(const pg8::f32x4*)(p + 4); }
#pragma unroll
        for (int vb = 0; vb < 8; ++vb)
#pragma unroll
            for (int j = 0; j < 8; ++j) vr[vb][j] = vbp[(size_t)(16 * (j >> 2) + 4 * kg + (j & 3)) * 512 + vb * 16 + n];
        pg8::f32x4 sc[2];
#pragma unroll
        for (int b2 = 0; b2 < 2; ++b2) { sc[b2] = (pg8::f32x4){0.f, 0.f, 0.f, 0.f};
#pragma unroll
            for (int ks = 0; ks < 4; ++ks) sc[b2] = MFMA16(pack8(kr[b2][ks][0], kr[b2][ks][1]), qf[ks], sc[b2]); }
        if (key0 >= PAST - 128) {
#pragma unroll
            for (int b2 = 0; b2 < 2; ++b2)
#pragma unroll
                for (int i = 0; i < 4; ++i) { int dist = PAST + qi - (key0 + b2 * 16 + kg * 4 + i); dist = dist > 127 ? 127 : dist; sc[b2][i] += BT[dist]; }
        }
        float mx = fmaxf(fmaxf(fmaxf(sc[0][0], sc[0][1]), fmaxf(sc[0][2], sc[0][3])), fmaxf(fmaxf(sc[1][0], sc[1][1]), fmaxf(sc[1][2], sc[1][3])));
        mx = fmaxf(mx, __shfl_xor(mx, 16)); mx = fmaxf(mx, __shfl_xor(mx, 32));
        const float mnew = fmaxf(mrun, mx), alpha = __builtin_amdgcn_exp2f(mrun - mnew); mrun = mnew;
        float ps = 0.f;
#pragma unroll
        for (int b2 = 0; b2 < 2; ++b2)
#pragma unroll
            for (int i = 0; i < 4; ++i) { sc[b2][i] = __builtin_amdgcn_exp2f(sc[b2][i] - mnew); ps += sc[b2][i]; }
        lrun = lrun * alpha + ps;
        const bf16x8 pf = pack8(sc[0], sc[1]);
#pragma unroll
        for (int vb = 0; vb < 8; ++vb) { o[vb] = o[vb] * alpha;
            o[vb] = MFMA16(pack8((pg8::f32x4){vr[vb][0], vr[vb][1], vr[vb][2], vr[vb][3]}, (pg8::f32x4){vr[vb][4], vr[vb][5], vr[vb][6], vr[vb][7]}), pf, o[vb]); }
    }
    if (wave == 0) {
        int l2 = lane; asm volatile("" : "+v"(l2)); const int n = l2 & 15, kg = l2 >> 4, qi = n & 7;
        const bf16* zr = Z + (size_t)(MP + s * TS) * PROJ;
        pg8::f32x4 sc0 = {0.f, 0.f, 0.f, 0.f};
#pragma unroll
        for (int ks = 0; ks < 4; ++ks) { v4u w = {0u, 0u, 0u, 0u};
            if (n < 8) w = *(const v4u*)(zr + (size_t)n * PROJ + 1024 + h * 128 + (ks >> 1) * 64 + (ks & 1) * 32 + kg * 8);
            sc0 = MFMA16(__builtin_bit_cast(bf16x8, w), qf[ks], sc0); }
#pragma unroll
        for (int i = 0; i < 4; ++i) { const int key = kg * 4 + i; const int dd = qi - key; sc0[i] = (key <= qi) ? sc0[i] + BT[dd < 0 ? 0 : dd] : -INFINITY; }
        float mx = fmaxf(fmaxf(sc0[0], sc0[1]), fmaxf(sc0[2], sc0[3]));
        mx = fmaxf(mx, __shfl_xor(mx, 16)); mx = fmaxf(mx, __shfl_xor(mx, 32));
        const float mnew = fmaxf(mrun, mx), alpha = __builtin_amdgcn_exp2f(mrun - mnew); mrun = mnew;
        float ps = 0.f;
#pragma unroll
        for (int i = 0; i < 4; ++i) { sc0[i] = __builtin_amdgcn_exp2f(sc0[i] - mnew); ps += sc0[i]; }
        lrun = lrun * alpha + ps;
        const bf16x8 pf = pack8(sc0, (pg8::f32x4){0.f, 0.f, 0.f, 0.f});
#pragma unroll
        for (int vb = 0; vb < 8; ++vb) { v4u w = {0u, 0u, 0u, 0u};
            if (kg < 2) { const bf16* vp = zr + (size_t)(kg * 4) * PROJ + 1536 + h * 128 + vb * 16 + n;
                w.x = (unsigned)vp[0] | ((unsigned)vp[PROJ] << 16); w.y = (unsigned)vp[2 * PROJ] | ((unsigned)vp[3 * PROJ] << 16); }
            o[vb] = o[vb] * alpha; o[vb] = MFMA16(__builtin_bit_cast(bf16x8, w), pf, o[vb]); }
    }
    lrun += __shfl_xor(lrun, 16); lrun += __shfl_xor(lrun, 32);
    LAS float* OT = (LAS float*)lds; LAS float* ML = (LAS float*)(lds + 8 * 16 * SA_OSTR * 4);
    { int l3 = lane; asm volatile("" : "+v"(l3)); const int n = l3 & 15, kg = l3 >> 4;
#pragma unroll
    for (int vb = 0; vb < 8; ++vb) *(LAS pg8::f32x4*)(OT + (wave * 16 + n) * SA_OSTR + vb * 16 + kg * 4) = o[vb];
    if (kg == 0) { ML[(wave * 16 + n) * 2] = mrun; ML[(wave * 16 + n) * 2 + 1] = lrun; } }
    __syncthreads();
    {
        const int i = wave; float oc[2][2];
#pragma unroll
        for (int c = 0; c < 2; ++c) { const int nn = c * 8 + i; float mxx = -INFINITY;
#pragma unroll
            for (int w2 = 0; w2 < 8; ++w2) mxx = fmaxf(mxx, ML[(w2 * 16 + nn) * 2]);
            float L = 0.f, A0 = 0.f, A1 = 0.f;
#pragma unroll
            for (int w2 = 0; w2 < 8; ++w2) { const float f = __builtin_amdgcn_exp2f(ML[(w2 * 16 + nn) * 2] - mxx); L += f * ML[(w2 * 16 + nn) * 2 + 1];
                A0 += f * OT[(w2 * 16 + nn) * SA_OSTR + lane]; A1 += f * OT[(w2 * 16 + nn) * SA_OSTR + 64 + lane]; }
            const float rl = 1.f / L; oc[c][0] = A0 * rl; oc[c][1] = A1 * rl; }
        const float r0 = oc[0][0] - lam * oc[1][0], r1 = oc[0][1] - lam * oc[1][1];
        const float rstd = 1.f / sqrtf(wave_sum(r0 * r0 + r1 * r1) * (1.f / 128.f) + EPS);
        const float* gh = a.in[I_GHEAD]; bf16* mix = (bf16*)(a.ws + WS_MIX) + (size_t)(MP + s * TS + i) * D + 512 + h * 128;
        mix[lane] = (bf16)(pkbf(r0 * rstd * gh[lane] * (1.f - LAM_INIT), 0.f) & 0xffffu);
        mix[lane + 64] = (bf16)(pkbf(r1 * rstd * gh[lane + 64] * (1.f - LAM_INIT), 0.f) & 0xffffu);
    }
    __syncthreads();
}
template <int W> __device__ __forceinline__ void pool_window(const float (&e0)[23], const float (&e1)[23], int pos0  , unsigned (&dpk)[8]) {
    float s0 = 0.f, s1 = 0.f;
#pragma unroll
    for (int r = 16 - W; r <= 15; ++r) { s0 += e0[r]; s1 += e1[r]; }
#pragma unroll
    for (int i = 0; i < 8; ++i) {
        if (i > 0) { s0 += e0[15 + i] - e0[15 + i - W]; s1 += e1[15 + i] - e1[15 + i - W]; }
        float cnt = (float)W; if (pos0 >= 0) { const int c = pos0 + i + 1; cnt = (float)(c < W ? c : W); }
        const float rc = 1.f / cnt;
        dpk[i] = pkbf(s0 * rc - e0[15 + i], s1 * rc - e1[15 + i]);
    }
}
constexpr int PD_STR = 136;
__device__ __forceinline__ void pool_item(const Args& a, LAS unsigned char* lds, int item, int tid) {
    const int wave = __builtin_amdgcn_readfirstlane(tid >> 6), lane = tid & 63, n = lane & 15, kg = lane >> 4;
    const int tile = item >> 2, g = item & 3, row0 = tile * 64 + wave * 8;
    const bf16* Z = (const bf16*)(a.ws + WS_Z);
    float e0[23], e1[23]; int pos0;
    if (row0 < MP) {
        const int t0 = row0 & (TP - 1); pos0 = t0;
#pragma unroll
        for (int r = 0; r < 23; ++r) { const int t = t0 - 15 + r; unsigned w = 0u;
            if (t >= 0) w = *(const unsigned*)(Z + (size_t)(row0 - 15 + r) * PROJ + g * 128 + 2 * lane);
            e0[r] = bflo(w); e1[r] = bfhi(w); }
    } else {
        const int s = (row0 - MP) >> 3; pos0 = -1; const float* sp = a.in[I_SP] + (size_t)s * 15 * 512 + g * 128 + 2 * lane;
#pragma unroll
        for (int r = 0; r < 15; ++r) { const f32x2 v = *(const f32x2*)(sp + (size_t)r * 512); e0[r] = v.x; e1[r] = v.y; }
#pragma unroll
        for (int r = 15; r < 23; ++r) { const unsigned w = *(const unsigned*)(Z + (size_t)(row0 + r - 15) * PROJ + g * 128 + 2 * lane); e0[r] = bflo(w); e1[r] = bfhi(w); }
        float* ps = a.out + O_PS + (size_t)s * 15 * 512 + g * 128 + 2 * lane;
#pragma unroll
        for (int r = 8; r < 15; ++r) *(f32x2*)(ps + (size_t)(r - 8) * 512) = (f32x2){e0[r], e1[r]};
    }
    unsigned dpk[8];
    if (g == 0) pool_window<2>(e0, e1, pos0, dpk); else if (g == 1) pool_window<4>(e0, e1, pos0, dpk); else if (g == 2) pool_window<8>(e0, e1, pos0, dpk); else pool_window<16>(e0, e1, pos0, dpk);
    LAS bf16* Dt = (LAS bf16*)lds;
#pragma unroll
    for (int i = 0; i < 8; ++i) *(LAS unsigned*)(Dt + (wave * 8 + i) * PD_STR + 2 * lane) = dpk[i];
    __syncthreads();
    const int rb = wave & 3, ch = wave >> 2;
    const bf16* wp = (const bf16*)(a.ws + WS_WPOOL) + (size_t)g * 16384;
    pg8::f32x4 acc[4];
#pragma unroll
    for (int nb = 0; nb < 4; ++nb) acc[nb] = (pg8::f32x4){0.f, 0.f, 0.f, 0.f};
#pragma unroll
    for (int ks = 0; ks < 4; ++ks) {
        const bf16x8 af = *(const LAS bf16x8*)(Dt + (rb * 16 + n) * PD_STR + ks * 32 + kg * 8);
#pragma unroll
        for (int nb = 0; nb < 4; ++nb) { const bf16x8 bf_ = *(const bf16x8*)(wp + (size_t)(ch * 64 + nb * 16 + n) * 128 + ks * 32 + kg * 8); acc[nb] = MFMA16(af, bf_, acc[nb]); }
    }
    const float* psc = a.in[I_PSCALE] + g * 128; bf16* mix = (bf16*)(a.ws + WS_MIX);
#pragma unroll
    for (int nb = 0; nb < 4; ++nb) { const int col = ch * 64 + nb * 16 + n; const float sc = psc[col];
#pragma unroll
        for (int i = 0; i < 4; ++i) mix[(size_t)(tile * 64 + rb * 16 + kg * 4 + i) * D + g * 128 + col] = (bf16)(pkbf(acc[nb][i] * sc, 0.f) & 0xffffu); }
    __syncthreads();
}
__device__ __forceinline__ void p4_combine(const Args& a, int gw, int NGW, int lane) {
    const float lam = lam_value(a, lane); const float* gh = a.in[I_GHEAD];
    const bf16* OB = (const bf16*)(a.ws + WS_OB); bf16* mix = (bf16*)(a.ws + WS_MIX);
    const int h = lane >> 4, vd0 = (lane & 15) * 8;
    const f32x4 g0 = *(const f32x4*)(gh + vd0), g1 = *(const f32x4*)(gh + vd0 + 4);
    for (int row = gw; row < MP; row += NGW) {
        const v4u w0 = *(const v4u*)(OB + (size_t)row * D + h * 256 + vd0), w1 = *(const v4u*)(OB + (size_t)row * D + h * 256 + 128 + vd0);
        float o[8];
        o[0] = bflo(w0.x) - lam * bflo(w1.x); o[1] = bfhi(w0.x) - lam * bfhi(w1.x); o[2] = bflo(w0.y) - lam * bflo(w1.y); o[3] = bfhi(w0.y) - lam * bfhi(w1.y);
        o[4] = bflo(w0.z) - lam * bflo(w1.z); o[5] = bfhi(w0.z) - lam * bfhi(w1.z); o[6] = bflo(w0.w) - lam * bflo(w1.w); o[7] = bfhi(w0.w) - lam * bfhi(w1.w);
        float ss = 0.f;
#pragma unroll
        for (int j = 0; j < 8; ++j) ss += o[j] * o[j];
        ss += __shfl_xor(ss, 1); ss += __shfl_xor(ss, 2); ss += __shfl_xor(ss, 4); ss += __shfl_xor(ss, 8);
        const float r = (1.f - LAM_INIT) / sqrtf(ss * (1.f / 128.f) + EPS);
        v4u w; w.x = pkbf(o[0] * r * g0.x, o[1] * r * g0.y); w.y = pkbf(o[2] * r * g0.z, o[3] * r * g0.w); w.z = pkbf(o[4] * r * g1.x, o[5] * r * g1.y); w.w = pkbf(o[6] * r * g1.z, o[7] * r * g1.w);
        *(v4u*)(mix + (size_t)row * D + 512 + h * 128 + vd0) = w;
    }
}
__device__ __forceinline__ float gelu_tanh(float x) { const float u = 1.5957691216057308f * (x + 0.044715f * x * x * x); return x / (1.f + __expf(-u)); }
__device__ __forceinline__ void unpack8(v4u w, float (&f)[8]) { f[0] = bflo(w.x); f[1] = bfhi(w.x); f[2] = bflo(w.y); f[3] = bfhi(w.y); f[4] = bflo(w.z); f[5] = bfhi(w.z); f[6] = bflo(w.w); f[7] = bfhi(w.w); }
__device__ __forceinline__ void p8_conv_geglu(const Args& a, int gtid, int NT) {
    const bf16* U = (const bf16*)(a.ws + WS_U); bf16* ACT = (bf16*)(a.ws + WS_ACT);
    const float* cw = a.in[I_CONVW]; const float* cb = a.in[I_CONVB]; const float* stc = a.in[I_SC];
    constexpr int NCH = FF / 8, NRUN = M / 8;
    for (int it = gtid; it < NRUN * NCH; it += NT) {
        const int run = it / NCH, j0 = (it % NCH) * 8, row0 = run * 8;
        float wg[3][8], wv[3][8], bg[8], bv[8];
#pragma unroll
        for (int k = 0; k < 3; ++k) { const f32x4 a0 = *(const f32x4*)(cw + k * UPW + j0), a1 = *(const f32x4*)(cw + k * UPW + j0 + 4), b0 = *(const f32x4*)(cw + k * UPW + FF + j0), b1 = *(const f32x4*)(cw + k * UPW + FF + j0 + 4);
            wg[k][0] = a0.x; wg[k][1] = a0.y; wg[k][2] = a0.z; wg[k][3] = a0.w; wg[k][4] = a1.x; wg[k][5] = a1.y; wg[k][6] = a1.z; wg[k][7] = a1.w;
            wv[k][0] = b0.x; wv[k][1] = b0.y; wv[k][2] = b0.z; wv[k][3] = b0.w; wv[k][4] = b1.x; wv[k][5] = b1.y; wv[k][6] = b1.z; wv[k][7] = b1.w; }
        { const f32x4 a0 = *(const f32x4*)(cb + j0), a1 = *(const f32x4*)(cb + j0 + 4), b0 = *(const f32x4*)(cb + FF + j0), b1 = *(const f32x4*)(cb + FF + j0 + 4);
            bg[0] = a0.x; bg[1] = a0.y; bg[2] = a0.z; bg[3] = a0.w; bg[4] = a1.x; bg[5] = a1.y; bg[6] = a1.z; bg[7] = a1.w;
            bv[0] = b0.x; bv[1] = b0.y; bv[2] = b0.z; bv[3] = b0.w; bv[4] = b1.x; bv[5] = b1.y; bv[6] = b1.z; bv[7] = b1.w; }
        float g2[8], g1[8], v2[8], v1[8];
        if (row0 < MP) {
            if ((row0 & (TP - 1)) == 0) {
#pragma unroll
                for (int j = 0; j < 8; ++j) { g2[j] = 0.f; g1[j] = 0.f; v2[j] = 0.f; v1[j] = 0.f; }
            } else {
                unpack8(*(const v4u*)(U + (size_t)(row0 - 2) * UPW + j0), g2); unpack8(*(const v4u*)(U + (size_t)(row0 - 1) * UPW + j0), g1);
                unpack8(*(const v4u*)(U + (size_t)(row0 - 2) * UPW + FF + j0), v2); unpack8(*(const v4u*)(U + (size_t)(row0 - 1) * UPW + FF + j0), v1);
            }
        } else {
            const float* sp = stc + (size_t)((row0 - MP) >> 3) * 2 * UPW + j0;
#pragma unroll
            for (int j = 0; j < 8; ++j) { g2[j] = sp[j]; g1[j] = sp[UPW + j]; v2[j] = sp[FF + j]; v1[j] = sp[UPW + FF + j]; }
        }
#pragma unroll
        for (int i = 0; i < 8; ++i) {
            float g0[8], v0[8];
            unpack8(*(const v4u*)(U + (size_t)(row0 + i) * UPW + j0), g0); unpack8(*(const v4u*)(U + (size_t)(row0 + i) * UPW + FF + j0), v0);
            float r[8];
#pragma unroll
            for (int j = 0; j < 8; ++j) { const float cg = bg[j] + wg[0][j] * g2[j] + wg[1][j] * g1[j] + wg[2][j] * g0[j], cv = bv[j] + wv[0][j] * v2[j] + wv[1][j] * v1[j] + wv[2][j] * v0[j];
                r[j] = gelu_tanh(cg) * cv; g2[j] = g1[j]; g1[j] = g0[j]; v2[j] = v1[j]; v1[j] = v0[j]; }
            v4u w; w.x = pkbf(r[0], r[1]); w.y = pkbf(r[2], r[3]); w.z = pkbf(r[4], r[5]); w.w = pkbf(r[6], r[7]);
            *(v4u*)(ACT + (size_t)(row0 + i) * FF + j0) = w;
        }
    }
}

#ifndef P3_SUB
#define P3_SUB 7
#endif
constexpr int N_PHASES = 11;
__global__ void __launch_bounds__(NWAVES * 64, 2) fwd_kernel(Args args) {
    extern __shared__ __attribute__((aligned(16))) unsigned char lds_raw[];
    LAS unsigned char* lds = (LAS unsigned char*)lds_raw;
    const int tid = threadIdx.x, lane = tid & 63, wave = __builtin_amdgcn_readfirstlane(tid >> 6);
    const int G = gridDim.x, bx = blockIdx.x, vcu = (G % 8 == 0) ? (bx % 8) * (G / 8) + bx / 8 : bx;
    const int gw = bx * NWAVES + wave, NGW = G * NWAVES;
    for (int u = tid; u < (LDS_BYTES - LDSCTL_OFF) / 4; u += NWAVES * 64) ((LAS unsigned*)(lds + LDSCTL_OFF))[u] = 0u;
    __syncthreads();
    volatile LAS unsigned* MISC = (volatile LAS unsigned*)(lds + MISC_OFF);
    unsigned* ctl = (unsigned*)(args.ws + WS_CTL);
    const bool use_bar = (args.ph_hi - args.ph_lo) > 1;
    XcdBarrier bar; bar.bar = ctl + CW_BAR; bar.x = 0; bar.st = nullptr;
    if (use_bar) bar = xcd_barrier_post(ctl + CW_BAR, MISC + 8);
    const int lo = args.ph_lo, hi = args.ph_hi;
#ifndef PH_MASK
#define PH_MASK 0xFFFF
#endif
#define IN(k) (((PH_MASK >> (k)) & 1) && lo <= (k) && (k) < hi)
#define SEAM(k) do { if (IN(k) && IN((k) + 1)) xcd_barrier(bar); } while (0)
#define WSP(off) ((bf16*)(args.ws + (off)))

    if (IN(0)) { p0_prologue(args, lds, tid, G); } SEAM(0);
    if (IN(1)) { p1_norm_in(args, gw, NGW, lane); } SEAM(1);
    if (IN(2)) {
        pg8::Gemm g{WSP(WS_XN), WSP(WS_WIN), M, PROJ, D}; pg8::StaticOrder S; S.init(M, PROJ, G, bx);
        EpiZ E{WSP(WS_Z), args.out};
        pg8::gemm_phase<EpiZ, pg8::StaticOrder, true, true>(lds, g, S, E);
    } SEAM(2);
    if (IN(3)) {
        build_bias_tables(args, lds, tid);
        {
            const int bh = vcu >> 3, b = bh >> 2, h = bh & 3, c = vcu & 1, vh = (vcu >> 1) & 1, hs = (vcu >> 2) & 1;
            if ((P3_SUB & 1) && vcu < 256) {
                for (int i = 0; i < 4; ++i) {
                    const int qb = hs ? ((i == 0) ? 2 : (i == 1) ? 5 : (i == 2) ? 3 : 4) : ((i == 0) ? 0 : (i == 1) ? 7 : (i == 2) ? 1 : 6);
                    attn_body::attn_unit<8>((long)b * TP, 512 + h * 128 + c * 64, 1024 + h * 128 + c * 64, 1536 + h * 128 + vh * 64, h * 256 + c * 128 + vh * 64, qb,
                                            (const attn_body::bf16*)(args.ws + WS_Z), (attn_body::bf16*)(args.ws + WS_OB), (char*)lds_raw, (attn_body::lds_cfptr)(lds + RT_OFF) + h * RT_N);
                }
            }
        }
        if (P3_SUB & 2) { const float lam = lam_value(args, lane); for (int u = vcu; u < NBS * 4; u += G) sattn_unit(args, lds, u >> 2, u & 3, lam, tid); }
        if (P3_SUB & 4) for (int it = vcu; it < (M / 64) * 4; it += G) pool_item(args, lds, it, tid);
    } SEAM(3);
    if (IN(4)) { p4_combine(args, gw, NGW, lane); } SEAM(4);
    if (IN(5)) {
        pg8::Gemm g{WSP(WS_MIX), WSP(WS_WOUT), M, D, D}; pg8::StaticOrder S; S.init(M, D, G, bx);
        EpiPlain E{WSP(WS_MO), D};
        pg8::gemm_phase<EpiPlain, pg8::StaticOrder, true, true>(lds, g, S, E);
    } SEAM(5);
    if (IN(6)) { p6_norm_mid(args, gw, NGW, lane); } SEAM(6);
    if (IN(7)) {
        pg8::Gemm g{WSP(WS_XN), WSP(WS_WUP), M, UPW, D}; pg8::StaticOrder S; S.init(M, UPW, G, bx);
        EpiU E{WSP(WS_U), args.out};
        pg8::gemm_phase<EpiU, pg8::StaticOrder, true, true>(lds, g, S, E);
    } SEAM(7);
    if (IN(8)) { p8_conv_geglu(args, bx * NWAVES * 64 + tid, G * NWAVES * 64); } SEAM(8);
    if (IN(9)) {
        pg8::Gemm g{WSP(WS_ACT), WSP(WS_WDN), M, D, FF}; pg8::StaticOrder S; S.init(M, D, G, bx);
        EpiPlain E{WSP(WS_F), D};
        pg8::gemm_phase<EpiPlain, pg8::StaticOrder, true, true>(lds, g, S, E);
    } SEAM(9);
    if (IN(10)) { p10_norm_out(args, gw, NGW, lane); }
#undef IN
#undef SEAM
}

#ifndef MK_N_LAUNCHES
#define MK_N_LAUNCHES 1
#endif
extern "C" void kernel_launch(void* const* d_in, const int* in_sizes, int n_in, void* d_out, int out_size, void* d_ws, size_t ws_size, hipStream_t stream) {
    static int grid = 0;
    if (grid == 0) {
        if (n_in != 29 || (size_t)out_size != O_END || ws_size < WS_END) { fprintf(stderr, "kernel_launch: unexpected shapes (n_in %d, out %d, ws %zu); nothing launched\n", n_in, out_size, ws_size); grid = -1; return; }
        int dev = 0, cus = 0, per_cu = 0;
        if (hipGetDevice(&dev) != hipSuccess || hipDeviceGetAttribute(&cus, hipDeviceAttributeMultiprocessorCount, dev) != hipSuccess) { grid = -1; return; }
        if (hipFuncSetAttribute((const void*)fwd_kernel, hipFuncAttributeMaxDynamicSharedMemorySize, LDS_BYTES) != hipSuccess) { fprintf(stderr, "kernel_launch: hipFuncSetAttribute failed\n"); grid = -1; return; }
        if (hipOccupancyMaxActiveBlocksPerMultiprocessor(&per_cu, (const void*)fwd_kernel, NWAVES * 64, LDS_BYTES) != hipSuccess || per_cu < 1) { fprintf(stderr, "kernel_launch: occupancy query reports %d workgroups per CU\n", per_cu); }
        (void)hipGetLastError();
        grid = cus;
        if (grid != 256) fprintf(stderr, "kernel_launch: %d CUs (expected 256)\n", grid);
    }
    if (grid < 0) return;
    (void)hipMemsetAsync((char*)d_ws + WS_CTL, 0, CTL_ZERO_BYTES, stream);
    Args a{};
    for (int i = 0; i < 29; ++i) a.in[i] = (const float*)d_in[i];
    a.out = (float*)d_out; a.ws = (unsigned char*)d_ws;
#if MK_N_LAUNCHES == 1
    a.ph_lo = 0; a.ph_hi = N_PHASES;
    hipLaunchKernelGGL(fwd_kernel, dim3(grid), dim3(NWAVES * 64), LDS_BYTES, stream, a);
#else
    for (int p = 0; p < N_PHASES; ++p) { a.ph_lo = p; a.ph_hi = p + 1; hipLaunchKernelGGL(fwd_kernel, dim3(grid), dim3(NWAVES * 64), LDS_BYTES, stream, a); }
#endif
}
```

```cpp
#include <hip/hip_runtime.h>
#include <hip/hip_bf16.h>
#include <cstdio>
#include <cstdint>
#include <cmath>
namespace pg8 {
#define PG8_LAS __attribute__((address_space(3)))
typedef unsigned short bf16_t;
typedef short bf16x8 __attribute__((ext_vector_type(8)));
typedef float f32x4 __attribute__((ext_vector_type(4)));
typedef unsigned u32x4 __attribute__((ext_vector_type(4)));
constexpr int BM = 256, BK = 64, HALF = 128, HTB = HALF * BK * 2  , STAGE_BYTES = 8 * HTB, NXCD = 8, WGM = 8;

__host__ __device__ __forceinline__ int lds_byte(int r, int c) { const int st = (r >> 4) * 2 + (c >> 5), rr = r & 15, cc = c & 31, ob = rr * 64 + cc * 2; return st * 1024 + (ob ^ (((ob >> 9) & 1) << 5)); }
__host__ __device__ __forceinline__ void stage_rc(int b, int& R, int& C) { const int st = b / 1024, sb = b % 1024, swz = sb ^ (((sb >> 9) & 1) << 5); R = (st >> 1) * 16 + swz / 64; C = (st & 1) * 32 + (swz % 64) / 2; }
__host__ __device__ __forceinline__ int perm32(int rho) { const int n = rho >> 4, i = rho & 15; return 8 * (i >> 2) + 4 * n + (i & 3); }

struct Unit { int pm, pn; };
struct Gemm { const bf16_t* A; const bf16_t* Bt; int M, N, K; };

struct StaticOrder {
    int nM, nN, nwg, G, c;
    __host__ __device__ void init(int M, int N, int G_, int c_) { nM = M / BM; nN = N / BM; nwg = nM * nN; G = G_; c = c_; }
    __host__ __device__ bool next(int i, Unit& u) const {
        const long L = (long)i * G + c; if (L >= nwg) return false;
        int wgid = (int)L; { const int q = nwg / NXCD, r = nwg % NXCD, xcd = wgid % NXCD, off = wgid / NXCD; wgid = (xcd < r ? xcd * (q + 1) : r * (q + 1) + (xcd - r) * q) + off; }
        const int nig = WGM * nN, gid = wgid / nig, fm = gid * WGM, gsz = (nM - fm) < WGM ? (nM - fm) : WGM;
        u.pm = fm + ((wgid % nig) % gsz); u.pn = (wgid % nig) / gsz; return true;
    }
    __device__ __forceinline__ void a_ready(const Unit&) const {}
    __device__ __forceinline__ void done(const Unit&) const {}
};

__device__ __forceinline__ unsigned cvt_pk_bf16(float lo, float hi) { unsigned r; asm volatile("v_cvt_pk_bf16_f32 %0, %1, %2" : "=v"(r) : "v"(lo), "v"(hi)); return r; }
typedef float f32x2 __attribute__((ext_vector_type(2)));
__device__ __forceinline__ f32x2 gelu_pk(f32x2 v) {
    const f32x2 av = __builtin_elementwise_abs(v), d = av * 0.2316418882f + 1.0f;
    f32x2 t; t.x = __builtin_amdgcn_rcpf(d.x); t.y = __builtin_amdgcn_rcpf(d.y);
    f32x2 q = t * 0.5307027145f + (-0.7265760135f); q = q * t + 0.7107068705f; q = q * t + (-0.142248368f); q = q * t + 0.127414796f; q = q * t;
    const f32x2 s = (v * v) * (-0.72134752044f);
    f32x2 e; e.x = __builtin_amdgcn_exp2f(s.x); e.y = __builtin_amdgcn_exp2f(s.y);
    const f32x2 m = v * (q * e), r = v - m;
    f32x2 o; o.x = v.x < 0.f ? m.x : r.x; o.y = v.y < 0.f ? m.y : r.y; return o;
}

template <int ACT  > struct EpiBf16 {
    static constexpr bool PERM = true, AFTER_DRAIN = false; static_assert(ACT == 0 || ACT == 1, "EpiBf16: ACT is 0 (none) or 1 (gelu_pk)");
    bf16_t* O; int ldc; const float* bias; int split_cols; size_t split_stride; float scale0;
    __device__ __forceinline__ void operator()(const f32x4 (&acc)[2][2][4][2], const Unit& u, int wr, int wc, int fr, int fq) const {
        const int row0 = u.pm * BM + wr * 64 + fr; int colt = u.pn * BM; bf16_t* base = O;
        float sc = 1.f; if (split_cols) { const int t = colt / split_cols; base += (size_t)t * split_stride; colt -= t * split_cols; if (t == 0) sc = scale0; }
        const int col0 = colt + wc * 32 + 8 * fq, bcol0 = u.pn * BM + wc * 32 + 8 * fq;
        f32x4 bv[2][2];
#pragma unroll
        for (int bj = 0; bj < 2; ++bj)
#pragma unroll
            for (int n = 0; n < 2; ++n) bv[bj][n] = bias ? *(const f32x4*)(bias + bcol0 + bj * HALF + 4 * n) : (f32x4){0.f, 0.f, 0.f, 0.f};
#pragma unroll
        for (int ai = 0; ai < 2; ++ai)
#pragma unroll
            for (int m = 0; m < 4; ++m) { bf16_t* rowp = base + (size_t)(row0 + ai * HALF + m * 16) * ldc + col0;
#pragma unroll
                for (int bj = 0; bj < 2; ++bj) { f32x4 v0 = acc[ai][bj][m][0] + bv[bj][0], v1 = acc[ai][bj][m][1] + bv[bj][1];
                    if (ACT == 1) { f32x2 a = gelu_pk((f32x2){v0[0], v0[1]}), b = gelu_pk((f32x2){v0[2], v0[3]}), c = gelu_pk((f32x2){v1[0], v1[1]}), d = gelu_pk((f32x2){v1[2], v1[3]});
                        v0 = (f32x4){a.x, a.y, b.x, b.y}; v1 = (f32x4){c.x, c.y, d.x, d.y}; }
                    v0 = v0 * sc; v1 = v1 * sc; u32x4 w; w.x = cvt_pk_bf16(v0[0], v0[1]); w.y = cvt_pk_bf16(v0[2], v0[3]); w.z = cvt_pk_bf16(v1[0], v1[1]); w.w = cvt_pk_bf16(v1[2], v1[3]);
                    *(u32x4*)(rowp + bj * HALF) = w; } }
    }
};
template <class Epi, class Sched, bool ALIGN_EPI = false, bool SP2 = false>
__device__ __forceinline__ void gemm_phase(PG8_LAS unsigned char* lds, const Gemm g, const Sched& S, const Epi& E) {
    const int tid = threadIdx.x, wid = __builtin_amdgcn_readfirstlane(tid >> 6), lane = tid & 63, wr = wid >> 2, wc = wid & 3, fr = lane & 15, fq = lane >> 4;
    const int K = g.K, nt = K / BK;
    unsigned voffA[2], voffB[2];
#pragma unroll
    for (int i = 0; i < 2; ++i) { int R, C; stage_rc(tid * 16 + i * 8192, R, C); const int Rb = Epi::PERM ? ((R & ~31) + perm32(R & 31)) : R;
        voffA[i] = (unsigned)(R * K + C) * 2u; voffB[i] = (unsigned)(Rb * K + C) * 2u; }
    const size_t kstep = (size_t)(BK * 2);
    const size_t hstep = (size_t)HALF * K * 2;
    const size_t tstep = 2 * hstep;
    const unsigned ldsw = (unsigned)wid * 1024u;
    const int aoff = lds_byte(wr * 64 + fr, fq * 8), boff = lds_byte(wc * 32 + fr, fq * 8);
#define PG8_SA(b, h) (((b) * 2 + (h)) * HTB)
#define PG8_SB(b, h) ((4 + (b) * 2 + (h)) * HTB)
#define PG8_STAGE(bufoff, gbase, voff) do { _Pragma("unroll") for (int _i = 0; _i < 2; ++_i) \
        __builtin_amdgcn_global_load_lds((const unsigned*)((const char*)(gbase) + (voff)[_i]), (PG8_LAS unsigned*)(lds + (bufoff) + ldsw + _i * 8192), 16, 0, 0); } while (0)
#define PG8_LDA(dst, b, h) do { _Pragma("unroll") for (int m = 0; m < 4; ++m) _Pragma("unroll") for (int k = 0; k < 2; ++k) dst[m][k] = *(const PG8_LAS bf16x8*)(lds + PG8_SA(b, h) + aoff + m * 2048 + k * 1024); } while (0)
#define PG8_LDB(dst, b, h) do { _Pragma("unroll") for (int n = 0; n < 2; ++n) _Pragma("unroll") for (int k = 0; k < 2; ++k) dst[n][k] = *(const PG8_LAS bf16x8*)(lds + PG8_SB(b, h) + boff + n * 2048 + k * 1024); } while (0)
#define PG8_MMA(ai, bj, At, Bt) do { __builtin_amdgcn_s_setprio(1); _Pragma("unroll") for (int m = 0; m < 4; ++m) _Pragma("unroll") for (int n = 0; n < 2; ++n) _Pragma("unroll") for (int k = 0; k < 2; ++k) \
        acc[ai][bj][m][n] = __builtin_amdgcn_mfma_f32_16x16x32_bf16(Bt[n][k], At[m][k], acc[ai][bj][m][n], 0, 0, 0); __builtin_amdgcn_s_setprio(0); } while (0)
#define PG8_WAIT_V(n) asm volatile("s_waitcnt vmcnt(" #n ")" ::: "memory")
#define PG8_WAIT_L(n) asm volatile("s_waitcnt lgkmcnt(" #n ")" ::: "memory")
#define PG8_BAR __builtin_amdgcn_s_barrier()
#define PG8_SCHED __builtin_amdgcn_sched_barrier(0)
    Unit cur, nxt; int ui = 0;
    if (!S.next(0, cur)) return;
    f32x4 acc[2][2][4][2];
#pragma unroll
    for (int a = 0; a < 2; ++a)
#pragma unroll
        for (int b = 0; b < 2; ++b)
#pragma unroll
            for (int m = 0; m < 4; ++m)
#pragma unroll
                for (int n = 0; n < 2; ++n) acc[a][b][m][n] = (f32x4){0.f, 0.f, 0.f, 0.f};
    bf16x8 At[4][2], B0[2][2], B1[2][2];
    const char* cA = (const char*)g.A + (size_t)cur.pm * tstep; const char* cB = (const char*)g.Bt + (size_t)cur.pn * tstep;
    S.a_ready(cur);
    if constexpr (SP2) {
        PG8_STAGE(PG8_SB(0, 0), cB, voffB); PG8_STAGE(PG8_SB(0, 1), cB + hstep, voffB); PG8_STAGE(PG8_SA(0, 0), cA, voffA); PG8_STAGE(PG8_SA(0, 1), cA + hstep, voffA);
        if (wr == 1) PG8_BAR;
        PG8_WAIT_V(2); PG8_BAR;
        PG8_STAGE(PG8_SB(1, 0), cB + kstep, voffB); PG8_STAGE(PG8_SA(1, 0), cA + kstep, voffA); PG8_STAGE(PG8_SB(1, 1), cB + hstep + kstep, voffB);
        PG8_WAIT_V(6); PG8_BAR;
    } else {
        PG8_STAGE(PG8_SB(0, 0), cB, voffB); PG8_STAGE(PG8_SA(0, 0), cA, voffA); PG8_STAGE(PG8_SB(0, 1), cB + hstep, voffB); PG8_STAGE(PG8_SA(0, 1), cA + hstep, voffA);
        if (wr == 1) PG8_BAR;
        PG8_WAIT_V(4); PG8_BAR;
        PG8_STAGE(PG8_SB(1, 0), cB + kstep, voffB); PG8_STAGE(PG8_SA(1, 0), cA + kstep, voffA); PG8_STAGE(PG8_SB(1, 1), cB + hstep + kstep, voffB);
        PG8_WAIT_V(6); PG8_BAR;
    }
    for (;;) {
        const bool has_next = S.next(ui + 1, nxt);
        const char* nA = has_next ? (const char*)g.A + (size_t)nxt.pm * tstep : cA; const char* nB = has_next ? (const char*)g.Bt + (size_t)nxt.pn * tstep : cB;
        for (int t = 0; t < nt; t += 2) {
            const bool last = (t == nt - 2);
            const char* a1 = cA + (size_t)(t + 1) * kstep;
            const char* a2 = last ? nA : cA + (size_t)(t + 2) * kstep; const char* b2 = last ? nB : cB + (size_t)(t + 2) * kstep;
            const char* a3 = a2 + kstep; const char* b3 = b2 + kstep;
            if (last && has_next) S.a_ready(nxt);
            if constexpr (SP2) {
            PG8_LDB(B0, 0, 0); PG8_LDB(B1, 0, 1); PG8_SCHED; PG8_LDA(At, 0, 0); PG8_STAGE(PG8_SA(1, 1), a1 + hstep, voffA);
            PG8_WAIT_V(8); PG8_WAIT_L(0); PG8_BAR; PG8_MMA(0, 0, At, B0); PG8_MMA(0, 1, At, B1); PG8_BAR; PG8_SCHED;
            PG8_LDA(At, 0, 1); PG8_STAGE(PG8_SB(0, 0), b2, voffB); PG8_STAGE(PG8_SB(0, 1), b2 + hstep, voffB); PG8_STAGE(PG8_SA(0, 0), a2, voffA);
            PG8_WAIT_V(8); PG8_WAIT_L(0); PG8_BAR; PG8_MMA(1, 0, At, B0); PG8_MMA(1, 1, At, B1); PG8_BAR; PG8_SCHED;
            PG8_LDB(B0, 1, 0); PG8_LDB(B1, 1, 1); PG8_SCHED; PG8_LDA(At, 1, 0); PG8_STAGE(PG8_SA(0, 1), a2 + hstep, voffA);
            PG8_WAIT_V(8); PG8_WAIT_L(0); PG8_BAR; PG8_MMA(0, 0, At, B0); PG8_MMA(0, 1, At, B1); PG8_BAR; PG8_SCHED;
            PG8_LDA(At, 1, 1); PG8_STAGE(PG8_SB(1, 0), b3, voffB); PG8_STAGE(PG8_SB(1, 1), b3 + hstep, voffB); PG8_STAGE(PG8_SA(1, 0), a3, voffA);
            PG8_WAIT_V(8); PG8_WAIT_L(0); PG8_BAR; PG8_MMA(1, 0, At, B0); PG8_MMA(1, 1, At, B1); PG8_BAR; PG8_SCHED;
            } else {
            PG8_LDB(B0, 0, 0); PG8_SCHED; PG8_LDA(At, 0, 0); PG8_STAGE(PG8_SA(1, 1), a1 + hstep, voffA);
            PG8_WAIT_L(8); PG8_BAR; PG8_WAIT_L(0); PG8_MMA(0, 0, At, B0); PG8_BAR; PG8_SCHED;
            PG8_LDB(B1, 0, 1); PG8_STAGE(PG8_SB(0, 0), b2, voffB);
            PG8_BAR; PG8_WAIT_L(0); PG8_MMA(0, 1, At, B1); PG8_BAR;
            PG8_LDA(At, 0, 1); PG8_STAGE(PG8_SA(0, 0), a2, voffA);
            PG8_BAR; PG8_WAIT_L(0); PG8_MMA(1, 0, At, B0); PG8_BAR; PG8_SCHED;
            PG8_STAGE(PG8_SB(0, 1), b2 + hstep, voffB);
            PG8_WAIT_V(6); PG8_BAR; PG8_MMA(1, 1, At, B1); PG8_BAR;
            PG8_LDB(B0, 1, 0); PG8_SCHED; PG8_LDA(At, 1, 0); PG8_STAGE(PG8_SA(0, 1), a2 + hstep, voffA);
            PG8_WAIT_L(8); PG8_BAR; PG8_WAIT_L(0); PG8_MMA(0, 0, At, B0); PG8_BAR; PG8_SCHED;
            PG8_LDB(B1, 1, 1); PG8_STAGE(PG8_SB(1, 0), b3, voffB);
            PG8_BAR; PG8_WAIT_L(0); PG8_MMA(0, 1, At, B1); PG8_BAR;
            PG8_LDA(At, 1, 1); PG8_STAGE(PG8_SA(1, 0), a3, voffA);
            PG8_BAR; PG8_WAIT_L(0); PG8_MMA(1, 0, At, B0); PG8_BAR; PG8_SCHED;
            PG8_STAGE(PG8_SB(1, 1), b3 + hstep, voffB);
            PG8_WAIT_V(6); PG8_BAR; PG8_MMA(1, 1, At, B1); PG8_BAR;
            }
        }
        if constexpr (ALIGN_EPI) { if (wr == 0) PG8_BAR; }
        if constexpr (!Epi::AFTER_DRAIN) { E(acc, cur, wr, wc, fr, fq); S.done(cur); }
        if (!has_next) break;
#pragma unroll
        for (int a = 0; a < 2; ++a)
#pragma unroll
            for (int b = 0; b < 2; ++b)
#pragma unroll
                for (int m = 0; m < 4; ++m)
#pragma unroll
                    for (int n = 0; n < 2; ++n) acc[a][b][m][n] = (f32x4){0.f, 0.f, 0.f, 0.f};
        cur = nxt; cA = nA; cB = nB; ++ui;
        if constexpr (ALIGN_EPI) { if (wr == 1) PG8_BAR; }
    }
    PG8_WAIT_V(0);
    if constexpr (!ALIGN_EPI) { if (wr == 0) PG8_BAR; }
    PG8_BAR;
    if constexpr (Epi::AFTER_DRAIN) { E.fused(acc, cur, wr, wc, fr, fq, lds, wid, lane); S.done(cur); }
#undef PG8_SA
#undef PG8_SB
#undef PG8_STAGE
#undef PG8_LDA
#undef PG8_LDB
#undef PG8_MMA
#undef PG8_WAIT_V
#undef PG8_WAIT_L
#undef PG8_BAR
#undef PG8_SCHED
}
}
constexpr int D = 1024, NBP = 8, TP = 2048, NBS = 128, TS = 8;
constexpr int MP = NBP * TP, MS = NBS * TS, M = MP + MS;
constexpr int PROJ = 2048, FF = 2816, UPW = 2 * FF, MODW = 6 * D, NMOD = NBP + NBS;
constexpr int PAGE = 128, NPAGES = 16, PAST = 2048;
constexpr float EPS = 1e-6f, LAM_INIT = 0.2f, LOG2E = 1.4426950408889634f;
constexpr float QSCALE = 0.125f * LOG2E;
constexpr size_t O_Y = 0, O_KP = (size_t)M * D, O_VP = O_KP + (size_t)MP * 512, O_PP = O_VP + (size_t)MP * 512, O_CP = O_PP + (size_t)NBP * 15 * 512,
                 O_KS = O_CP + (size_t)NBP * 2 * UPW, O_VS = O_KS + (size_t)MS * 512, O_PS = O_VS + (size_t)MS * 512, O_CS = O_PS + (size_t)NBS * 15 * 512, O_END = O_CS + (size_t)NBS * 2 * UPW;
static_assert(O_END == 38227968, "output size");
constexpr size_t MiB = 1u << 20;
constexpr size_t WS_CTL = 0, CTL_ZERO_BYTES = 32768;
constexpr size_t WS_MOD = 1 * MiB, WS_WIN = 5 * MiB, WS_WOUT = 9 * MiB, WS_WUP = 11 * MiB, WS_WDN = 22 * MiB, WS_WPOOL = 28 * MiB;
constexpr size_t WS_XN = 32 * MiB, WS_Z = 66 * MiB, WS_OB = 134 * MiB, WS_MIX = 166 * MiB, WS_MO = 200 * MiB, WS_U = 234 * MiB, WS_ACT = 421 * MiB, WS_F = 515 * MiB, WS_X1 = 549 * MiB, WS_UH = 583 * MiB, WS_END = 590 * MiB;
static_assert(WS_MOD + (size_t)NMOD * MODW * 4 <= WS_WIN && WS_WUP + (size_t)UPW * D * 2 <= WS_WDN && WS_WDN + (size_t)D * FF * 2 <= WS_WPOOL, "ws map 1");
static_assert(WS_XN + (size_t)M * D * 2 <= WS_Z && WS_Z + (size_t)M * PROJ * 2 <= WS_OB && WS_OB + (size_t)MP * D * 2 <= WS_MIX && WS_MIX + (size_t)M * D * 2 <= WS_MO && WS_MO + (size_t)M * D * 2 <= WS_U, "ws map 2");
static_assert(WS_U + (size_t)M * UPW * 2 <= WS_ACT && WS_ACT + (size_t)M * FF * 2 <= WS_F && WS_F + (size_t)M * D * 2 <= WS_X1 && WS_X1 + (size_t)M * D * 2 <= WS_UH && WS_UH + (size_t)(MP / 256) * 4 * UPW * 4 <= WS_END, "ws map 3");
constexpr int CW_BAR = 4096;
constexpr int RING_BYTES = 131072, LDSCTL_OFF = RING_BYTES, MISC_OFF = LDSCTL_OFF + 320, LDS_BYTES = 147456;
constexpr int RT_OFF = 98304, RT_N = 704, BT_OFF = RT_OFF + 4 * RT_N * 4;
static_assert(BT_OFF + 4 * 128 * 4 <= RING_BYTES, "bias tables inside the ring region");
constexpr int NWAVES = 8;

#include <hip/hip_bf16.h>
#include <cmath>
namespace attn_body {
using bf16=__hip_bfloat16;
using bf16x8=__attribute__((ext_vector_type(8)))short;
using s16x4=__attribute__((ext_vector_type(4)))short;
using f32x16=__attribute__((ext_vector_type(16)))float;
using u32x4=__attribute__((ext_vector_type(4)))unsigned;
constexpr int SEQ=2048,D=64,ZP=2048,OP=1024;
constexpr int NW=8,QBLK=32,QB=QBLK*NW,KVBLK=64,NQB=SEQ/QB;
constexpr int ATTN_UNIT_ROWS=QB;
__device__ __forceinline__ int crow(int r,int hi){return (r&3)+8*(r>>2)+4*hi;}
#define SBAR() __builtin_amdgcn_sched_barrier(0)
typedef __attribute__((address_space(3))) const float* lds_cfptr;
__device__ __forceinline__ void cmask(f32x16&p0,f32x16&p1,int jb,int qrel,int hi,lds_cfptr rtab){
  const float NEG=-INFINITY; int kb=64*jb+4*hi;
  lds_cfptr rp=rtab+(447-qrel+kb);
  #pragma unroll
  for(int r=0;r<16;++r){const int kvl=(r&3)+8*(r>>2); p0[r]+=rp[kvl]; p1[r]+=rp[kvl+32];}
  if(jb>=0){
  #pragma unroll
  for(int r=0;r<16;++r){int kv=kb+(r&3)+8*(r>>2); if(kv>qrel)p0[r]=NEG; if(kv+32>qrel)p1[r]=NEG;}
  }
}

constexpr int NSLOT=3, SLOTB=8192;
constexpr int LDS_K=0, LDS_V=NSLOT*SLOTB, LDS_WS=2*NSLOT*SLOTB, LDS_OST=LDS_WS+NW*64*4, LDS_BYTES=LDS_OST+NW*4096;
constexpr float C2=0.125f*1.4426950408889634f;
__device__ __forceinline__ void glds16(const void*gsrc,unsigned lds_dst){unsigned keep;
  asm volatile("s_mov_b32 %0, m0\n\ts_mov_b32 m0, %2\n\ts_nop 0\n\tglobal_load_lds_dwordx4 %1, off\n\ts_mov_b32 m0, %0":"=&s"(keep):"v"(gsrc),"s"(lds_dst):"memory");}
__device__ __forceinline__ float max3f(float a,float b,float c){float r;asm("v_max3_f32 %0, %1, %2, %3":"=v"(r):"v"(a),"v"(b),"v"(c));return r;}
__device__ __forceinline__ float max2f(float a,float b){float r;asm("v_max_f32_e32 %0, %1, %2":"=v"(r):"v"(a),"v"(b));return r;}
__device__ __forceinline__ float fadd_s(float a,float b){float r;asm("v_add_f32_e32 %0, %1, %2":"=v"(r):"v"(a),"v"(b));return r;}
__device__ __forceinline__ float fsub_s(float a,float b){float r;asm("v_sub_f32_e32 %0, %1, %2":"=v"(r):"v"(a),"v"(b));return r;}
typedef float f32x2_t __attribute__((ext_vector_type(2))); typedef __bf16 bf16x2_t __attribute__((ext_vector_type(2)));
__device__ __forceinline__ unsigned cvtpk_s(float lo,float hi){f32x2_t v={lo,hi};bf16x2_t b=__builtin_convertvector(v,bf16x2_t);return __builtin_bit_cast(unsigned,b);}
#define WAIT_BAR(N) asm volatile("s_waitcnt vmcnt(" #N ") lgkmcnt(0)\n\ts_barrier":::"memory")

__device__ __forceinline__ void qkt(f32x16&p0,f32x16&p1,const char*Kslot,const bf16x8*qr,int r32,int hi){
  const char*kb=Kslot+hi*1024+r32*16;
  #pragma unroll
  for(int d0=0;d0<4;++d0){
    const bf16x8 b0=*reinterpret_cast<const bf16x8*>(kb+d0*2048);
    const bf16x8 b1=*reinterpret_cast<const bf16x8*>(kb+d0*2048+512);
    if(d0==0){p0=__builtin_amdgcn_mfma_f32_32x32x16_bf16(b0,qr[0],f32x16{},0,0,0);p1=__builtin_amdgcn_mfma_f32_32x32x16_bf16(b1,qr[0],f32x16{},0,0,0);}
    else{p0=__builtin_amdgcn_mfma_f32_32x32x16_bf16(b0,qr[d0],p0,0,0,0);p1=__builtin_amdgcn_mfma_f32_32x32x16_bf16(b1,qr[d0],p1,0,0,0);}}
}
typedef __attribute__((address_space(3))) const char* lds_cptr;
typedef short v4i16_t __attribute__((ext_vector_type(4)));
__device__ __forceinline__ void kload8(bf16x8*kf,lds_cptr kp){
  kf[0]=*(const __attribute__((address_space(3))) bf16x8*)(kp);      kf[1]=*(const __attribute__((address_space(3))) bf16x8*)(kp+512);
  kf[2]=*(const __attribute__((address_space(3))) bf16x8*)(kp+2048); kf[3]=*(const __attribute__((address_space(3))) bf16x8*)(kp+2560);
  kf[4]=*(const __attribute__((address_space(3))) bf16x8*)(kp+4096); kf[5]=*(const __attribute__((address_space(3))) bf16x8*)(kp+4608);
  kf[6]=*(const __attribute__((address_space(3))) bf16x8*)(kp+6144); kf[7]=*(const __attribute__((address_space(3))) bf16x8*)(kp+6656);
}
__device__ __forceinline__ void kload2(bf16x8*kf,lds_cptr kp,int j){ kf[2*j]=*(const __attribute__((address_space(3))) bf16x8*)(kp+j*2048); kf[2*j+1]=*(const __attribute__((address_space(3))) bf16x8*)(kp+j*2048+512); }
__device__ __forceinline__ s16x4 vtr(lds_cptr p){ return __builtin_bit_cast(s16x4,__builtin_amdgcn_ds_read_tr16_b64_v4i16((__attribute__((address_space(3))) v4i16_t*)p)); }
__device__ __forceinline__ float rowmax(const f32x16&p0,const f32x16&p1){
  float a=max3f(p0[0],p0[1],p1[0]),b=max3f(p0[2],p0[3],p1[1]);a=max3f(a,p1[2],p1[3]);
  #pragma unroll
  for(int r=4;r<16;r+=4){a=max3f(a,p0[r],p0[r+1]);b=max3f(b,p0[r+2],p0[r+3]);a=max3f(a,p1[r],p1[r+1]);b=max3f(b,p1[r+2],p1[r+3]);}
  const float m=max2f(a,b);
  auto rr=__builtin_amdgcn_permlane32_swap(__float_as_uint(m),__float_as_uint(m),false,false);
  return max2f(__uint_as_float(rr[0]),__uint_as_float(rr[1]));
}
__device__ __forceinline__ void pv(f32x16*o,int vb,bf16x8 pa0,bf16x8 pa1,bf16x8 pa2,bf16x8 pa3){
  #pragma unroll
  for(int d0=0;d0<2;++d0){s16x4 lo[4],hi[4];
    #pragma unroll
    for(int ks=0;ks<4;++ks){
      asm volatile("ds_read_b64_tr_b16 %0,%1 offset:%c2":"=&v"(lo[ks]):"v"(vb),"i"(d0*4096+ks*1024):"memory");
      asm volatile("ds_read_b64_tr_b16 %0,%1 offset:%c2":"=&v"(hi[ks]):"v"(vb),"i"(d0*4096+ks*1024+512):"memory");}
    asm volatile("s_waitcnt lgkmcnt(0)":::"memory");SBAR();
    #define PK(k) (bf16x8){lo[k][0],lo[k][1],lo[k][2],lo[k][3],hi[k][0],hi[k][1],hi[k][2],hi[k][3]}
    o[d0]=__builtin_amdgcn_mfma_f32_32x32x16_bf16(pa0,PK(0),o[d0],0,0,0);
    o[d0]=__builtin_amdgcn_mfma_f32_32x32x16_bf16(pa1,PK(1),o[d0],0,0,0);
    o[d0]=__builtin_amdgcn_mfma_f32_32x32x16_bf16(pa2,PK(2),o[d0],0,0,0);
    o[d0]=__builtin_amdgcn_mfma_f32_32x32x16_bf16(pa3,PK(3),o[d0],0,0,0);
    #undef PK
  }
}

#ifndef ATTN_STORE16
#define ATTN_STORE16(p,v) (*(u32x4*)(p)=(v))
#endif
template<int THRL> __device__ __forceinline__ void attn_unit(long rowbase,int qcol,int kcol,int vcol,int ocol,int qb,const bf16*__restrict__ Z,bf16*O,char*shm,lds_cfptr rtab){
  int tid_=threadIdx.x; asm volatile("":"+v"(tid_));
  const int tid=tid_,lane=tid&63,r32=lane&31,hi=lane>>5; const int wid=__builtin_amdgcn_readfirstlane(tid>>6);
  const int q0=qb*QB;
  const bf16*Qw=Z+(rowbase+q0+wid*QBLK)*ZP+qcol;
  const bf16*Kh=Z+rowbase*ZP+kcol,*Vh=Z+rowbase*ZP+vcol;
  const unsigned lds0=(unsigned)(uintptr_t)shm;
  float*wsf=(float*)(shm+LDS_WS)+wid*64;
  const bf16*ksrc=Kh+(long)lane*ZP+wid*8;
  const bf16*vsrc=Vh+(long)(16*(wid&3)+(lane>>2))*ZP+(wid>>2)*32+(lane&3)*8;
  const unsigned kdst=lds0+LDS_K+wid*1024, vdst=lds0+LDS_V+wid*1024;
  #define DMA_K(t,slot) glds16(ksrc+(long)(t)*KVBLK*ZP,(unsigned)__builtin_amdgcn_readfirstlane(kdst+(slot)))
  #define DMA_V(t,slot) glds16(vsrc+(long)(t)*KVBLK*ZP,(unsigned)__builtin_amdgcn_readfirstlane(vdst+(slot)))
  const int vb0=(int)(lds0+LDS_V)+((lane>>4)&1)*32+(lane&3)*8+(4*hi+((lane&15)>>2))*64;
  const char*Kbase=shm+LDS_K; bf16x8 kf[8];
  const lds_cptr shm3=(lds_cptr)shm; const lds_cptr kp0=shm3+LDS_K+hi*1024+r32*16; const lds_cptr vp0=shm3+LDS_V+((lane>>4)&1)*32+(lane&3)*8+(4*hi+((lane&15)>>2))*64;
  const int NT=(q0+QB)/KVBLK;
  DMA_K(0,0);DMA_V(0,0);DMA_K(1,SLOTB);
  bf16x8 qr[4];
  #pragma unroll
  for(int d0=0;d0<4;++d0)qr[d0]=*reinterpret_cast<const bf16x8*>(&Qw[(long)r32*ZP+d0*16+hi*8]);
  float mhat=0.f,l_reg=0.f;f32x16 o[2];o[0]=f32x16{};o[1]=f32x16{};
  const int qrel=wid*QBLK+r32;
  #define CMASK(P0,P1,t) do{int jb_=(t)-(NT-4); if(jb_>=-3)cmask(P0,P1,jb_,qrel,hi,rtab);}while(0)
  bool resc=false;
  #define START(P0,P1) do{ const float rm=rowmax(P0,P1); resc=false; mhat=rm; \
    _Pragma("unroll") for(int r=0;r<16;++r)P0[r]=__builtin_amdgcn_exp2f(fsub_s(P0[r],mhat)); }while(0)
  #define RESC() do{ if(resc){ asm volatile("s_waitcnt lgkmcnt(0)":::"memory"); \
      _Pragma("unroll") for(int d_=0;d_<2;++d_) _Pragma("unroll") for(int r=0;r<16;++r)o[d_][r]*=wsf[crow(r,hi)]; } }while(0)
  f32x16 pA0,pA1,pB0,pB1;
  int sl_prev=0,sl_cur=0,sl_next=SLOTB;
  #define ROT() do{sl_prev=sl_cur;sl_cur=sl_next;sl_next=(sl_next==(NSLOT-1)*SLOTB)?0:sl_next+SLOTB;}while(0)
  DMA_K(2,2*SLOTB);
  WAIT_BAR(3);
  qkt(pA0,pA1,Kbase,qr,r32,hi);asm volatile("s_nop 15\n\ts_nop 7":"+v"(pA0),"+v"(pA1));CMASK(pA0,pA1,0);
  START(pA0,pA1);
  _Pragma("unroll") for(int r=0;r<16;++r)pA1[r]=__builtin_amdgcn_exp2f(pA1[r]-mhat);
  WAIT_BAR(0);
  DMA_K(3,0);DMA_V(1,SLOTB);
  ROT();
  kload8(kf,kp0+sl_cur);
  WAIT_BAR(2);
  s16x4 vlo[8],vhi[8]; u32x4 pw0,pw1,pw2,pw3;
  #define PKW(P,B) cvtpk_s(P[B],P[B+1])
  #define PAF(k) __builtin_bit_cast(bf16x8,pw##k)
  #define VFR(i) (bf16x8){vlo[i][0],vlo[i][1],vlo[i][2],vlo[i][3],vhi[i][0],vhi[i][1],vhi[i][2],vhi[i][3]}
  #define PIN(x) asm volatile("":"+v"(x))
  #define MX3(a,b,c) __builtin_fmaxf(__builtin_fmaxf((a),(b)),(c))
  #define GAPA(MF,A0,A1,A2,A3,W0,W1,PW) do{ MF; sacc+=A0; sacc+=A1; sacc+=A2; sacc+=A3; PIN(sacc); W0; W1; PIN(PW); SBAR(); }while(0)
  #define EX(v) __builtin_amdgcn_exp2f(v)
  #define GAPB(MF,X,B) do{ MF; X[B]=EX(X[B]-mhat); X[B+1]=EX(X[B+1]-mhat); X[B+2]=EX(X[B+2]-mhat); X[B+3]=EX(X[B+3]-mhat); PIN(X); SBAR(); }while(0)
  #define VRD(i) do{ vlo[i]=vtr(vp_+(((i)>>2)*4096+((i)&3)*1024)); vhi[i]=vtr(vp_+(((i)>>2)*4096+((i)&3)*1024+512)); }while(0)
  #define KRD(G,j) do{ if(G){ kload2(kf,kp0+sl_next,j); SBAR(); } }while(0)
  #define STEP(C0,C1,P0,P1,t,GK,GV,GL) do{ SBAR(); \
    const lds_cptr vp_=vp0+sl_prev; \
    VRD(0); SBAR(); float sacc=(P0[0]+P0[1]); \
    GAPA(C0=__builtin_amdgcn_mfma_f32_32x32x16_bf16(kf[0],qr[0],f32x16{},0,0,0), P0[2],P0[3],P0[4],P0[5],     pw0[0]=PKW(P0,0), pw0[1]=PKW(P0,2), pw0); \
    VRD(4); SBAR(); GAPA(C1=__builtin_amdgcn_mfma_f32_32x32x16_bf16(kf[1],qr[0],f32x16{},0,0,0), P0[6],P0[7],P0[8],P0[9],     pw0[2]=PKW(P0,4), pw0[3]=PKW(P0,6), pw0); \
    VRD(1); SBAR(); GAPA(C0=__builtin_amdgcn_mfma_f32_32x32x16_bf16(kf[2],qr[1],C0,0,0,0),   P0[10],P0[11],P0[12],P0[13], pw1[0]=PKW(P0,8), pw1[1]=PKW(P0,10), pw1); \
    VRD(5); SBAR(); GAPA(C1=__builtin_amdgcn_mfma_f32_32x32x16_bf16(kf[3],qr[1],C1,0,0,0),   P0[14],P0[15],P1[0],P1[1],   pw1[2]=PKW(P0,12),pw1[3]=PKW(P0,14), pw1); \
    VRD(2); SBAR(); GAPA(C0=__builtin_amdgcn_mfma_f32_32x32x16_bf16(kf[4],qr[2],C0,0,0,0),   P1[2],P1[3],P1[4],P1[5],     pw2[0]=PKW(P1,0), pw2[1]=PKW(P1,2), pw2); \
    VRD(6); SBAR(); GAPA(C1=__builtin_amdgcn_mfma_f32_32x32x16_bf16(kf[5],qr[2],C1,0,0,0),   P1[6],P1[7],P1[8],P1[9],     pw2[2]=PKW(P1,4), pw2[3]=PKW(P1,6), pw2); \
    VRD(3); SBAR(); GAPA(C0=__builtin_amdgcn_mfma_f32_32x32x16_bf16(kf[6],qr[3],C0,0,0,0),   P1[10],P1[11],P1[12],P1[13], pw3[0]=PKW(P1,8), pw3[1]=PKW(P1,10), pw3); \
    VRD(7); SBAR(); GAPA(C1=__builtin_amdgcn_mfma_f32_32x32x16_bf16(kf[7],qr[3],C1,0,0,0),   P1[14],P1[15],0.f,0.f,       pw3[2]=PKW(P1,12),pw3[3]=PKW(P1,14), pw3); \
    l_reg+=sacc; \
    if(GK){DMA_K((t)+3,sl_cur);} if(GV){DMA_V((t)+1,sl_next);} \
    CMASK(C0,C1,t); \
    { float a=MX3(C0[0],C0[1],C1[0]),b=MX3(C0[2],C0[3],C1[1]); a=MX3(a,C1[2],C1[3]); \
      _Pragma("unroll") for(int r=4;r<16;r+=4){a=MX3(a,C0[r],C0[r+1]);b=MX3(b,C0[r+2],C0[r+3]);a=MX3(a,C1[r],C1[r+1]);b=MX3(b,C1[r+2],C1[r+3]);} \
      float rm=__builtin_fmaxf(a,b); { auto rr=__builtin_amdgcn_permlane32_swap(__float_as_uint(rm),__float_as_uint(rm),false,false); rm=__builtin_fmaxf(__uint_as_float(rr[0]),__uint_as_float(rr[1])); } \
      resc=false; rm-=mhat; \
      if(__builtin_expect(__any(rm>(float)THRL),0)){ const float dl=__builtin_fmaxf(rm,0.f); mhat+=dl; \
        const float f=__builtin_amdgcn_exp2f(-dl); l_reg*=f; if(hi==0)wsf[r32]=f; resc=true; } } \
    SBAR(); \
    GAPB(o[0]=__builtin_amdgcn_mfma_f32_32x32x16_bf16(PAF(0),VFR(0),o[0],0,0,0), C0,0); \
    GAPB(o[1]=__builtin_amdgcn_mfma_f32_32x32x16_bf16(PAF(0),VFR(4),o[1],0,0,0), C0,4); \
    KRD(GL,0); GAPB(o[0]=__builtin_amdgcn_mfma_f32_32x32x16_bf16(PAF(1),VFR(1),o[0],0,0,0), C0,8); \
    KRD(GL,1); GAPB(o[1]=__builtin_amdgcn_mfma_f32_32x32x16_bf16(PAF(1),VFR(5),o[1],0,0,0), C0,12); \
    KRD(GL,2); GAPB(o[0]=__builtin_amdgcn_mfma_f32_32x32x16_bf16(PAF(2),VFR(2),o[0],0,0,0), C1,0); \
    KRD(GL,3); GAPB(o[1]=__builtin_amdgcn_mfma_f32_32x32x16_bf16(PAF(2),VFR(6),o[1],0,0,0), C1,4); \
    GAPB(o[0]=__builtin_amdgcn_mfma_f32_32x32x16_bf16(PAF(3),VFR(3),o[0],0,0,0), C1,8); \
    GAPB(o[1]=__builtin_amdgcn_mfma_f32_32x32x16_bf16(PAF(3),VFR(7),o[1],0,0,0), C1,12); \
    }while(0)
  int t=1;
  #undef CMASK
  #define CMASK(P0,P1,t) do{}while(0)
  for(;t+7<NT;t+=2){
    STEP(pB0,pB1,pA0,pA1,t,true,true,true);     WAIT_BAR(2); RESC(); ROT();
    STEP(pA0,pA1,pB0,pB1,t+1,true,true,true);   WAIT_BAR(2); RESC(); ROT();
  }
  #undef CMASK
  #define CMASK(P0,P1,t) do{int jb_=(t)-(NT-4); if(jb_>=-3)cmask(P0,P1,jb_,qrel,hi,rtab);}while(0)
  #define ENDW(tt) do{ if((tt)+3<NT){WAIT_BAR(2);} else if((tt)+2<NT){WAIT_BAR(1);} else {WAIT_BAR(0);} }while(0)
  for(;t+1<NT;t+=2){
    STEP(pB0,pB1,pA0,pA1,t,(t+3<NT),(t+1<NT),(t+1<NT));       ENDW(t);   RESC(); ROT();
    STEP(pA0,pA1,pB0,pB1,t+1,(t+4<NT),(t+2<NT),(t+2<NT));     ENDW(t+1); RESC(); ROT();
  }
  STEP(pB0,pB1,pA0,pA1,NT-1,false,false,false); RESC();
  { float sacc=pB0[0]+pB0[1]; _Pragma("unroll") for(int r=2;r<16;++r)sacc+=pB0[r]; _Pragma("unroll") for(int r=0;r<16;++r)sacc+=pB1[r]; l_reg+=sacc;
    pw0=(u32x4){PKW(pB0,0),PKW(pB0,2),PKW(pB0,4),PKW(pB0,6)};pw1=(u32x4){PKW(pB0,8),PKW(pB0,10),PKW(pB0,12),PKW(pB0,14)};pw2=(u32x4){PKW(pB1,0),PKW(pB1,2),PKW(pB1,4),PKW(pB1,6)};pw3=(u32x4){PKW(pB1,8),PKW(pB1,10),PKW(pB1,12),PKW(pB1,14)};
    SBAR(); pv(o,vb0+sl_cur,PAF(0),PAF(1),PAF(2),PAF(3)); }
  #undef PKW
  #undef PAF
  #undef VFR
  #undef PIN
  #undef MX3
  #undef GAPA
  #undef GAPB
  #undef EX
  #undef VRD
  #undef KRD
  #undef STEP
  #undef ENDW
  {auto rr=__builtin_amdgcn_permlane32_swap(__float_as_uint(l_reg),__float_as_uint(l_reg),false,false);l_reg=__uint_as_float(rr[0])+__uint_as_float(rr[1]);}
  if(hi==0)wsf[32+r32]=l_reg;asm volatile("s_waitcnt lgkmcnt(0)":::"memory");
  float rli[16];
  #pragma unroll
  for(int r=0;r<16;++r)rli[r]=__builtin_amdgcn_rcpf(wsf[32+crow(r,hi)]);
  bf16*Ow=O+(rowbase+q0+wid*QBLK)*OP+ocol;
  { bf16*stg=(bf16*)(shm+LDS_OST)+wid*2048;
    #pragma unroll
    for(int r=0;r<16;++r){const int orow=crow(r,hi);
      #pragma unroll
      for(int d0=0;d0<2;++d0)stg[orow*64+d0*32+r32]=__float2bfloat16(o[d0][r]*rli[r]);}
    asm volatile("s_waitcnt lgkmcnt(0)":::"memory");
    #pragma unroll
    for(int i=0;i<4;++i){const int row=i*8+(lane>>3),ch=lane&7; const u32x4 v=*(const u32x4*)(stg+row*64+ch*8); ATTN_STORE16(Ow+(long)row*OP+ch*8,v);} }
  asm volatile("s_waitcnt lgkmcnt(0)\n\ts_barrier":::"memory");
  #undef DMA_K
  #undef DMA_V
  #undef CMASK
  #undef START
  #undef RESC
  #undef ROT
}
constexpr int ATTN_LDS_BYTES=LDS_BYTES;
#undef SBAR
#undef WAIT_BAR
}
#define GAS __attribute__((address_space(1)))
#define LAS __attribute__((address_space(3)))
typedef unsigned short bf16;
typedef unsigned v4u __attribute__((ext_vector_type(4)));
typedef float f32x4 __attribute__((ext_vector_type(4)));
typedef short bf16x8 __attribute__((ext_vector_type(8)));
typedef GAS unsigned gu32;
typedef GAS unsigned long long gu64;
#define RLX_AGENT __ATOMIC_RELAXED, __HIP_MEMORY_SCOPE_AGENT
#define LDS_WAIT() asm volatile("s_waitcnt lgkmcnt(0)" ::: "memory")
#define VM_WAIT() asm volatile("s_waitcnt vmcnt(0)" ::: "memory")
__device__ __forceinline__ unsigned long long rt() { return __builtin_amdgcn_s_memrealtime(); }
__device__ __forceinline__ unsigned f2bf(float f) { unsigned u = __builtin_bit_cast(unsigned, f); return (u + 0x7fffu + ((u >> 16) & 1u)) >> 16; }
__device__ __forceinline__ unsigned pk2(float lo, float hi) { return f2bf(lo) | (f2bf(hi) << 16); }
#define XB_TMO      128
#define XB_XCNT(j)  (256  + 64 * (j))
#define XB_XSUB(j)  (1280 + 64 * (j))
#define XB_XGEN(j)  (2304 + 64 * (j))
#define XB_TOP      3328
#define XB_TOPGEN   3392
#define XCD_BAR_WORDS 3456
#define XB_SPIN_CAP (1u << 18)

__device__ __forceinline__ unsigned xb_ld(unsigned* p)              { return __hip_atomic_load(p, __ATOMIC_RELAXED, __HIP_MEMORY_SCOPE_AGENT); }
__device__ __forceinline__ unsigned xb_add(unsigned* p, unsigned v) { return __hip_atomic_fetch_add(p, v, __ATOMIC_RELAXED, __HIP_MEMORY_SCOPE_AGENT); }
__device__ __forceinline__ unsigned xb_xcc_id() { return (unsigned)__builtin_amdgcn_s_getreg((3 << 11) | 20) & 0xFu; }
#define XB_SPIN(cond, bar) do { unsigned _sp = 0; while (cond) { __builtin_amdgcn_s_sleep(1); \
    if ((++_sp & 255u) == 0u) { if (xb_ld(&(bar)[XB_TMO])) break; if (_sp > XB_SPIN_CAP) { atomicAdd(&(bar)[XB_TMO], 1u); break; } } } } while (0)

struct XcdBarrier {
    unsigned* bar; unsigned x;
    volatile LAS unsigned* st;
};

__device__ __forceinline__ XcdBarrier xcd_barrier_post(unsigned* bar, volatile LAS unsigned* st) {
    XcdBarrier b; b.bar = bar; b.x = xb_xcc_id(); b.st = st;
    if (threadIdx.x == 0) (void)xb_add(&bar[XB_XCNT(b.x)], 1u);
    return b;
}
__device__ __forceinline__ void xcd_barrier_complete(unsigned* bar, unsigned x, unsigned& nloc, unsigned& nx) {
    const unsigned G = gridDim.x * gridDim.y * gridDim.z;
    unsigned sum, cnt, mine, sp = 0u;
    for (;;) {
        sum = 0u; cnt = 0u; mine = 0u;
#pragma unroll
        for (unsigned j = 0; j < 16; ++j) { const unsigned c = xb_ld(&bar[XB_XCNT(j)]); sum += c; cnt += (c > 0u) ? 1u : 0u; mine = (j == x) ? c : mine; }
        if (sum == G) break;
        __builtin_amdgcn_s_sleep(1);
        if ((++sp & 255u) == 0u) { if (xb_ld(&bar[XB_TMO])) break; if (sp > XB_SPIN_CAP) { atomicAdd(&bar[XB_TMO], 1u); break; } }
    }
    nloc = mine > 0u ? mine : 1u; nx = cnt > 0u ? cnt : 1u;
}

__device__ __forceinline__ void xcd_barrier(const XcdBarrier& b) {
    asm volatile("s_waitcnt vmcnt(0)" ::: "memory");
    __syncthreads();
    if (threadIdx.x == 0) {
        unsigned* bar = b.bar;
        __builtin_amdgcn_s_waitcnt(0);
        unsigned nloc = b.st[0], nx = b.st[1];
        if (nloc == 0u) { xcd_barrier_complete(bar, b.x, nloc, nx); b.st[0] = nloc; b.st[1] = nx; }
        const unsigned old = xb_add(&bar[XB_XSUB(b.x)], 1u);
        const unsigned gen = old / nloc;
        if (old + 1u == (gen + 1u) * nloc) {
            __builtin_amdgcn_fence(__ATOMIC_RELEASE, "agent");
            asm volatile("s_waitcnt vmcnt(0)" ::: "memory");
            const unsigned og = xb_add(&bar[XB_TOP], 1u);
            const unsigned tg = og / nx;
            if (og + 1u == (tg + 1u) * nx) xb_add(&bar[XB_TOPGEN], 1u);
            else XB_SPIN(xb_ld(&bar[XB_TOPGEN]) == tg, bar);
            __builtin_amdgcn_fence(__ATOMIC_ACQUIRE, "agent");
            xb_add(&bar[XB_XGEN(b.x)], 1u);
            asm volatile("s_waitcnt vmcnt(0)" ::: "memory");
        } else {
            XB_SPIN(xb_ld(&bar[XB_XGEN(b.x)]) == gen, bar);
            __builtin_amdgcn_fence(__ATOMIC_ACQUIRE, "agent");
            asm volatile("s_waitcnt vmcnt(0)" ::: "memory");
        }
    }
    __syncthreads();
}

typedef unsigned v2u __attribute__((ext_vector_type(2)));
typedef float f32x2 __attribute__((ext_vector_type(2)));
typedef __bf16 bf16x2v __attribute__((ext_vector_type(2)));
__device__ __forceinline__ unsigned pkbf(float lo, float hi) { f32x2 v = {lo, hi}; bf16x2v b = __builtin_convertvector(v, bf16x2v); return __builtin_bit_cast(unsigned, b); }
__device__ __forceinline__ float bflo(unsigned w) { return __builtin_bit_cast(float, w << 16); }
__device__ __forceinline__ float bfhi(unsigned w) { return __builtin_bit_cast(float, w & 0xffff0000u); }
__device__ __forceinline__ float wave_sum(float v) {
#pragma unroll
    for (int o = 1; o < 64; o <<= 1) v += __shfl_xor(v, o);
    return v;
}
__device__ __forceinline__ bf16x8 pack8(f32x4 a, f32x4 b) { v4u w; w.x = pkbf(a[0], a[1]); w.y = pkbf(a[2], a[3]); w.z = pkbf(b[0], b[1]); w.w = pkbf(b[2], b[3]); return __builtin_bit_cast(bf16x8, w); }
#define MFMA16(a, b, c) __builtin_amdgcn_mfma_f32_16x16x32_bf16((a), (b), (c), 0, 0, 0)

struct Args { const float* in[29]; float* out; unsigned char* ws; int ph_lo, ph_hi; };
static_assert(sizeof(Args) == 256, "Args has no padding");
enum { I_XP = 0, I_XS, I_CP, I_CS, I_CK, I_CV, I_PT, I_SP, I_SC, I_WADA, I_BADA, I_GPM, I_GQM, I_GPF, I_GQF, I_WIN, I_WOUT, I_WPOOL, I_PSCALE,
       I_LQ1, I_LK1, I_LQ2, I_LK2, I_GHEAD, I_RELB, I_WUP, I_CONVW, I_CONVB, I_WDN };

struct EpiZ {
    static constexpr bool PERM = true, AFTER_DRAIN = false;
    bf16* Z; float* out;
    __device__ __forceinline__ void operator()(const pg8::f32x4 (&acc)[2][2][4][2], const pg8::Unit& u, int wr, int wc, int fr, int fq) const {
        const int region = u.pn >> 1;
        const float sc = region == 1 ? QSCALE : 1.f;
        const int rowt = u.pm * 256 + wr * 64 + fr, colt = u.pn * 256 + wc * 32 + 8 * fq, colr = colt - region * 512;
#pragma unroll
        for (int ai = 0; ai < 2; ++ai)
#pragma unroll
            for (int m = 0; m < 4; ++m) {
                const int row = rowt + ai * 128 + m * 16;
                bf16* zp = Z + (size_t)row * PROJ + colt;
#pragma unroll
                for (int bj = 0; bj < 2; ++bj) { const pg8::f32x4 v0 = acc[ai][bj][m][0] * sc, v1 = acc[ai][bj][m][1] * sc;
                    v4u w; w.x = pkbf(v0[0], v0[1]); w.y = pkbf(v0[2], v0[3]); w.z = pkbf(v1[0], v1[1]); w.w = pkbf(v1[2], v1[3]); *(v4u*)(zp + bj * 128) = w; }
                float* op = nullptr;
                if (region >= 2) {
                    op = (row < MP) ? out + (region == 2 ? O_KP : O_VP) + (size_t)row * 512 : out + (region == 2 ? O_KS : O_VS) + (size_t)(row - MP) * 512;
                } else if (region == 0) {
                    if (row < MP) { const int t = row & (TP - 1); if (t >= TP - 15) op = out + O_PP + (size_t)((row >> 11) * 15 + (t - (TP - 15))) * 512; }
                    else { const int r = row - MP; op = out + O_PS + (size_t)((r >> 3) * 15 + 7 + (r & 7)) * 512; }
                }
                if (op) {
#pragma unroll
                    for (int bj = 0; bj < 2; ++bj) { *(pg8::f32x4*)(op + colr + bj * 128) = acc[ai][bj][m][0]; *(pg8::f32x4*)(op + colr + bj * 128 + 4) = acc[ai][bj][m][1]; }
                }
            }
    }
};
struct EpiPlain {
    static constexpr bool PERM = true, AFTER_DRAIN = false;
    bf16* O; int ldc;
    __device__ __forceinline__ void operator()(const pg8::f32x4 (&acc)[2][2][4][2], const pg8::Unit& u, int wr, int wc, int fr, int fq) const {
        const int rowt = u.pm * 256 + wr * 64 + fr, colt = u.pn * 256 + wc * 32 + 8 * fq;
#pragma unroll
        for (int ai = 0; ai < 2; ++ai)
#pragma unroll
            for (int m = 0; m < 4; ++m) {
                bf16* zp = O + (size_t)(rowt + ai * 128 + m * 16) * ldc + colt;
#pragma unroll
                for (int bj = 0; bj < 2; ++bj) { const pg8::f32x4 v0 = acc[ai][bj][m][0], v1 = acc[ai][bj][m][1];
                    v4u w; w.x = pkbf(v0[0], v0[1]); w.y = pkbf(v0[2], v0[3]); w.z = pkbf(v1[0], v1[1]); w.w = pkbf(v1[2], v1[3]); *(v4u*)(zp + bj * 128) = w; }
            }
    }
};
__device__ __forceinline__ float gelu_tanh(float x) { const float u = -2.3022081981748974f * (x + 0.044715f * x * x * x); return x * __builtin_amdgcn_rcpf(1.f + __builtin_amdgcn_exp2f(u)); }
__device__ __forceinline__ float dpp_ror1(float x) { return __builtin_bit_cast(float, __builtin_amdgcn_update_dpp(0, __builtin_bit_cast(int, x), 0x121, 0xf, 0xf, false)); }
__device__ __forceinline__ float dpp_ror2(float x) { return __builtin_bit_cast(float, __builtin_amdgcn_update_dpp(0, __builtin_bit_cast(int, x), 0x122, 0xf, 0xf, false)); }
struct EpiConvGlu {
    static constexpr bool PERM = true, AFTER_DRAIN = false;
    bf16* ACT; float* UH; float* out; const float* cw; const float* cb; LAS unsigned char* xl;
    __device__ __forceinline__ void operator()(const pg8::f32x4 (&acc)[2][2][4][2], const pg8::Unit& u, int wr, int wc, int fr, int fq) const {
        const int rowt = u.pm * 256 + wr * 64 + fr, jg0 = u.pn * 128 + wc * 32 + 8 * fq;
        LAS pg8::f32x4* X = (LAS pg8::f32x4*)xl; LAS float* Pm = (LAS float*)(xl + 8192);
        if (fr >= 14) {
#pragma unroll
            for (int ai = 0; ai < 2; ++ai) { const int b = (((((ai * 2 + wr) * 4 + wc) * 4 + fq) * 2) + (fr - 14)) * 4;
                X[b] = acc[ai][0][3][0]; X[b + 1] = acc[ai][0][3][1]; X[b + 2] = acc[ai][1][3][0]; X[b + 3] = acc[ai][1][3][1]; }
        }
        { const int t = ((wr * 4 + wc) * 4 + fq) * 16 + fr;
#pragma unroll
          for (int i = 0; i < 2; ++i) { const int idx = t + 512 * i, p = idx >> 8, c = idx & 255, col = (c < 128 ? 0 : FF - 128) + u.pn * 128 + c; Pm[idx] = p < 3 ? cw[p * UPW + col] : cb[col]; } }
        asm volatile("s_waitcnt vmcnt(0) lgkmcnt(0)" ::: "memory"); __builtin_amdgcn_s_barrier(); asm volatile("" ::: "memory");
        const bool l15 = fr == 15, l14 = fr >= 14;
        const int pc = wc * 32 + 8 * fq;
#pragma unroll
        for (int ai = 0; ai < 2; ++ai) {
            pg8::f32x4 pv[4];
            const int o = ai * 2 + wr;
            if (o == 0) { pv[0] = (pg8::f32x4){0.f, 0.f, 0.f, 0.f}; pv[1] = pv[0]; pv[2] = pv[0]; pv[3] = pv[0]; }
            else { const int b = ((((((o - 1) * 4 + wc) * 4 + fq) * 2) + (l14 ? fr - 14 : 0))) * 4; pv[0] = X[b]; pv[1] = X[b + 1]; pv[2] = X[b + 2]; pv[3] = X[b + 3]; }
#pragma unroll
            for (int m = 0; m < 4; ++m) {
                const pg8::f32x4 cur[4] = {acc[ai][0][m][0], acc[ai][0][m][1], acc[ai][1][m][0], acc[ai][1][m][1]};
                unsigned pk[4];
#pragma unroll
                for (int n = 0; n < 2; ++n) {
                    asm volatile("" ::: "memory");
                    const pg8::f32x4 w0g = *(const LAS pg8::f32x4*)(Pm + pc + 4 * n), w1g = *(const LAS pg8::f32x4*)(Pm + 256 + pc + 4 * n), w2g = *(const LAS pg8::f32x4*)(Pm + 512 + pc + 4 * n), bg = *(const LAS pg8::f32x4*)(Pm + 768 + pc + 4 * n);
                    const pg8::f32x4 w0v = *(const LAS pg8::f32x4*)(Pm + 128 + pc + 4 * n), w1v = *(const LAS pg8::f32x4*)(Pm + 384 + pc + 4 * n), w2v = *(const LAS pg8::f32x4*)(Pm + 640 + pc + 4 * n), bv = *(const LAS pg8::f32x4*)(Pm + 896 + pc + 4 * n);
                    float r[4];
#pragma unroll
                    for (int k = 0; k < 4; ++k) { const float gv = cur[n][k], vv_ = cur[2 + n][k];
                        const float g1 = dpp_ror1(l15 ? pv[n][k] : gv), g2 = dpp_ror2(l14 ? pv[n][k] : gv);
                        const float v1 = dpp_ror1(l15 ? pv[2 + n][k] : vv_), v2 = dpp_ror2(l14 ? pv[2 + n][k] : vv_);
                        const float gc = bg[k] + w0g[k] * g2 + w1g[k] * g1 + w2g[k] * gv, vc = bv[k] + w0v[k] * v2 + w1v[k] * v1 + w2v[k] * vv_;
                        r[k] = gelu_tanh(gc) * vc; }
                    pk[2 * n] = pkbf(r[0], r[1]); pk[2 * n + 1] = pkbf(r[2], r[3]);
                }
                const int row = rowt + ai * 128 + m * 16;
                { v4u w; w.x = pk[0]; w.y = pk[1]; w.z = pk[2]; w.w = pk[3]; *(v4u*)(ACT + (size_t)row * FF + jg0) = w; }
                if (o == 0 && m == 0 && fr < 2) { float* hp = UH + (size_t)(u.pm * 4 + fr) * UPW + jg0;
                    *(pg8::f32x4*)hp = cur[0]; *(pg8::f32x4*)(hp + 4) = cur[1]; *(pg8::f32x4*)(hp + FF) = cur[2]; *(pg8::f32x4*)(hp + FF + 4) = cur[3]; }
                if (o == 3 && m == 3 && l14) { float* hp = UH + (size_t)(u.pm * 4 + 2 + (fr - 14)) * UPW + jg0;
                    *(pg8::f32x4*)hp = cur[0]; *(pg8::f32x4*)(hp + 4) = cur[1]; *(pg8::f32x4*)(hp + FF) = cur[2]; *(pg8::f32x4*)(hp + FF + 4) = cur[3];
                    if ((u.pm & 7) == 7) { float* op = out + O_CP + (size_t)((u.pm >> 3) * 2 + (fr - 14)) * UPW + jg0;
                        *(pg8::f32x4*)op = cur[0]; *(pg8::f32x4*)(op + 4) = cur[1]; *(pg8::f32x4*)(op + FF) = cur[2]; *(pg8::f32x4*)(op + FF + 4) = cur[3]; } }
#pragma unroll
                for (int q = 0; q < 4; ++q) pv[q] = cur[q];
            }
        }
    }
};
struct EpiConvGluS {
    static constexpr bool PERM = true, AFTER_DRAIN = false;
    bf16* ACT; float* out; const float* cw; const float* cb; const float* stc; LAS unsigned char* xl;
    __device__ __forceinline__ void operator()(const pg8::f32x4 (&acc)[2][2][4][2], const pg8::Unit& u, int wr, int wc, int fr_in, int fq_in) const {
        (void)fr_in; (void)fq_in;
        int ln_ = __builtin_amdgcn_mbcnt_hi(~0u, __builtin_amdgcn_mbcnt_lo(~0u, 0u)); asm volatile("" : "+v"(ln_)); const int fr = ln_ & 15, fq = ln_ >> 4;
        const int rowt = u.pm * 256 + wr * 64 + fr, jg0 = u.pn * 128 + wc * 32 + 8 * fq;
        { LAS float* Pw = (LAS float*)(xl + 8192); const int t = ((wr * 4 + wc) * 4 + fq) * 16 + fr;
#pragma unroll
          for (int i = 0; i < 2; ++i) { const int idx = t + 512 * i, p = idx >> 8, c = idx & 255, col = (c < 128 ? 0 : FF - 128) + u.pn * 128 + c; Pw[idx] = p < 3 ? cw[p * UPW + col] : cb[col]; } }
        asm volatile("s_waitcnt vmcnt(0) lgkmcnt(0)" ::: "memory"); __builtin_amdgcn_s_barrier(); asm volatile("" ::: "memory");
        unsigned pb_ = (unsigned)(uintptr_t)(xl + 8192) + (unsigned)(wc * 32 + 8 * fq) * 4u; asm volatile("" : "+v"(pb_));
        const LAS float* Pm = (const LAS float*)(uintptr_t)pb_;
        const bool i0 = (fr & 7) == 0, i1 = (fr & 7) == 1;
#pragma unroll
        for (int ai = 0; ai < 2; ++ai)
#pragma unroll
            for (int m = 0; m < 4; ++m) {
                const pg8::f32x4 cur[4] = {acc[ai][0][m][0], acc[ai][0][m][1], acc[ai][1][m][0], acc[ai][1][m][1]};
                const int row = rowt + ai * 128 + m * 16, rr = row - MP;
                const float* sp = stc + (size_t)(rr >> 3) * 2 * UPW + jg0;
                unsigned pk[4];
#pragma unroll
                for (int n = 0; n < 2; ++n) {
                    asm volatile("" ::: "memory");
                    const pg8::f32x4 w0g = *(const LAS pg8::f32x4*)(Pm + 4 * n), w1g = *(const LAS pg8::f32x4*)(Pm + 256 + 4 * n), w2g = *(const LAS pg8::f32x4*)(Pm + 512 + 4 * n), bg = *(const LAS pg8::f32x4*)(Pm + 768 + 4 * n);
                    const pg8::f32x4 w0v = *(const LAS pg8::f32x4*)(Pm + 128 + 4 * n), w1v = *(const LAS pg8::f32x4*)(Pm + 384 + 4 * n), w2v = *(const LAS pg8::f32x4*)(Pm + 640 + 4 * n), bv = *(const LAS pg8::f32x4*)(Pm + 896 + 4 * n);
                    pg8::f32x4 s0g = {0.f, 0.f, 0.f, 0.f}, s1g = s0g, s0v = s0g, s1v = s0g;
                    if (i0 || i1) { s1g = *(const pg8::f32x4*)(sp + UPW + 4 * n); s1v = *(const pg8::f32x4*)(sp + UPW + FF + 4 * n); }
                    if (i0) { s0g = *(const pg8::f32x4*)(sp + 4 * n); s0v = *(const pg8::f32x4*)(sp + FF + 4 * n); }
                    float r[4];
#pragma unroll
                    for (int k = 0; k < 4; ++k) { const float gv = cur[n][k], vv_ = cur[2 + n][k];
                        float g1 = dpp_ror1(gv), g2 = dpp_ror2(gv), v1 = dpp_ror1(vv_), v2 = dpp_ror2(vv_);
                        if (i0) { g1 = s1g[k]; g2 = s0g[k]; v1 = s1v[k]; v2 = s0v[k]; } else if (i1) { g2 = s1g[k]; v2 = s1v[k]; }
                        const float gc = bg[k] + w0g[k] * g2 + w1g[k] * g1 + w2g[k] * gv, vc = bv[k] + w0v[k] * v2 + w1v[k] * v1 + w2v[k] * vv_;
                        r[k] = gelu_tanh(gc) * vc; }
                    pk[2 * n] = pkbf(r[0], r[1]); pk[2 * n + 1] = pkbf(r[2], r[3]);
                }
                { v4u w; w.x = pk[0]; w.y = pk[1]; w.z = pk[2]; w.w = pk[3]; *(v4u*)(ACT + (size_t)row * FF + jg0) = w; }
                if ((fr & 7) >= 6) { float* op = out + O_CS + (size_t)((rr >> 3) * 2 + ((rr & 7) - 6)) * UPW + jg0;
                    *(pg8::f32x4*)op = cur[0]; *(pg8::f32x4*)(op + 4) = cur[1]; *(pg8::f32x4*)(op + FF) = cur[2]; *(pg8::f32x4*)(op + FF + 4) = cur[3]; }
            }
    }
};
struct SampleOrder {
    int c, c0;
    __device__ __forceinline__ bool next(int i, pg8::Unit& u) const { const int k = c - c0; if (i > 0 || k < 0 || k >= (MS / 256) * (UPW / 256)) return false; u.pm = MP / 256 + (k & 3); u.pn = k >> 2; return true; }
    __device__ __forceinline__ void a_ready(const pg8::Unit&) const {}
    __device__ __forceinline__ void done(const pg8::Unit&) const {}
};
constexpr int ST_STR = 272, ST_BUF = 64 * ST_STR;
template <class Epi, int MR = 1> __device__ __forceinline__ void gemm_small_tile(LAS unsigned char* lds, const bf16* A, const bf16* Bt, int K, int row0, int col0, int tid, const Epi& E) {
    const int wave = __builtin_amdgcn_readfirstlane(tid >> 6), lane = tid & 63, m = lane & 15, kg = lane >> 4, mb = wave & 3, nh = wave >> 2;
    constexpr int BUFB = (MR + 1) * ST_BUF, BOFF = MR * ST_BUF;
    const int pr0 = tid >> 4, pc = tid & 15;
    const bf16* ga = A + (size_t)(row0 + pr0) * K + pc * 8; const bf16* gb = Bt + (size_t)(col0 + pr0) * K + pc * 8;
    const int so = pr0 * ST_STR + pc * 16;
    const int ra = (mb * MR * 16 + m) * ST_STR + kg * 16, rb0 = BOFF + (nh * 32 + m) * ST_STR + kg * 16, rb1 = rb0 + 16 * ST_STR;
    pg8::f32x4 acc[MR][2];
#pragma unroll
    for (int j = 0; j < MR; ++j) { acc[j][0] = (pg8::f32x4){0.f, 0.f, 0.f, 0.f}; acc[j][1] = acc[j][0]; }
    constexpr int NSET = (MR == 1) ? 4 : 2;
    v4u Ra[NSET][2 * MR], Rb[NSET][2];
#define ST_LOAD(c_, r_) do { const int ko_ = (c_) * 128; _Pragma("unroll") for (int i_ = 0; i_ < 2 * MR; ++i_) Ra[r_][i_] = *(const v4u*)(ga + (size_t)(32 * i_) * K + ko_); _Pragma("unroll") for (int i_ = 0; i_ < 2; ++i_) Rb[r_][i_] = *(const v4u*)(gb + (size_t)(32 * i_) * K + ko_); } while (0)
#define ST_STORE(b_, r_) do { LAS unsigned char* d_ = lds + (b_) * BUFB; _Pragma("unroll") for (int i_ = 0; i_ < 2 * MR; ++i_) *(LAS v4u*)(d_ + so + 32 * i_ * ST_STR) = Ra[r_][i_]; _Pragma("unroll") for (int i_ = 0; i_ < 2; ++i_) *(LAS v4u*)(d_ + BOFF + so + 32 * i_ * ST_STR) = Rb[r_][i_]; } while (0)
#define ST_COMP(b_) do { const LAS unsigned char* s_ = lds + (b_) * BUFB; _Pragma("unroll") for (int ks = 0; ks < 4; ++ks) { \
        const bf16x8 b0 = *(const LAS bf16x8*)(s_ + rb0 + ks * 64), b1 = *(const LAS bf16x8*)(s_ + rb1 + ks * 64); \
        _Pragma("unroll") for (int j = 0; j < MR; ++j) { const bf16x8 af = *(const LAS bf16x8*)(s_ + ra + j * 16 * ST_STR + ks * 64); acc[j][0] = MFMA16(b0, af, acc[j][0]); acc[j][1] = MFMA16(b1, af, acc[j][1]); } } } while (0)
#define ST_STEP(c_, k_) do { const int cc_ = (c_) + (k_); if (cc_ < nch) { ST_COMP(cc_ & 1); if (cc_ + 1 < nch) ST_STORE((cc_ + 1) & 1, ((k_) + 1) % NSET); if (cc_ + 1 + NSET < nch) ST_LOAD(cc_ + 1 + NSET, ((k_) + 1) % NSET); __syncthreads(); } } while (0)
    const int nch = K >> 7;
#pragma unroll
    for (int r = 0; r < NSET; ++r) if (r < nch) ST_LOAD(r, r);
    ST_STORE(0, 0); if (NSET < nch) ST_LOAD(NSET, 0);
    __syncthreads();
    for (int c = 0; c < nch; c += NSET) {
#pragma unroll
        for (int k = 0; k < NSET; ++k) ST_STEP(c, k);
    }
#undef ST_LOAD
#undef ST_STORE
#undef ST_COMP
#undef ST_STEP
#pragma unroll
    for (int j = 0; j < MR; ++j) { const int row = row0 + (mb * MR + j) * 16 + m, col = col0 + nh * 32 + kg * 4; E(row, col, acc[j][0]); E(row, col + 16, acc[j][1]); }
}
struct SEpiZ {
    bf16* Z; float* out;
    __device__ __forceinline__ void operator()(int row, int col, pg8::f32x4 v) const {
        const int region = col >> 9, r = row - MP; const float sc = region == 1 ? QSCALE : 1.f;
        v2u w; w.x = pkbf(v[0] * sc, v[1] * sc); w.y = pkbf(v[2] * sc, v[3] * sc); *(v2u*)(Z + (size_t)row * PROJ + col) = w;
        if (region >= 2) *(pg8::f32x4*)(out + (region == 2 ? O_KS : O_VS) + (size_t)r * 512 + (col - region * 512)) = v;
        else if (region == 0) *(pg8::f32x4*)(out + O_PS + (size_t)((r >> 3) * 15 + 7 + (r & 7)) * 512 + col) = v;
    }
};
struct SEpiPlain { bf16* O; int ldc;
    __device__ __forceinline__ void operator()(int row, int col, pg8::f32x4 v) const { v2u w; w.x = pkbf(v[0], v[1]); w.y = pkbf(v[2], v[3]); *(v2u*)(O + (size_t)row * ldc + col) = w; }
};

template <bool UPMAP = false> __device__ __forceinline__ void p0_transpose_item(const float* W, int K, int N, bf16* WT, LAS float* scr, int item, int lane) {
    const int nblk = N / 32, kb = item / nblk, nb = item % nblk, k0 = 64 * kb, n0 = 32 * nb;
    const int r0 = !UPMAP ? n0 : (n0 < FF ? 256 * (n0 >> 7) + (n0 & 127) : 256 * ((n0 - FF) >> 7) + 128 + ((n0 - FF) & 127));
#pragma unroll 8
    for (int i = 0; i < 32; ++i) { const int kk = 2 * i + (lane >> 5); scr[kk * 33 + (lane & 31)] = W[(size_t)(k0 + kk) * N + n0 + (lane & 31)]; }
    LDS_WAIT(); asm volatile("" ::: "memory");
    const int c = lane & 7;
#pragma unroll
    for (int j = 0; j < 4; ++j) { const int n = (lane >> 3) + 8 * j; const LAS float* s = scr + (8 * c) * 33 + n;
        v4u o; o.x = pkbf(s[0 * 33], s[1 * 33]); o.y = pkbf(s[2 * 33], s[3 * 33]); o.z = pkbf(s[4 * 33], s[5 * 33]); o.w = pkbf(s[6 * 33], s[7 * 33]);
        *(GAS v4u*)(WT + (size_t)(r0 + n) * K + k0 + 8 * c) = o; }
    LDS_WAIT(); asm volatile("" ::: "memory");
}
__device__ __forceinline__ float silu_f(float x) { return x * __builtin_amdgcn_rcpf(1.f + __builtin_amdgcn_exp2f(-1.4426950408889634f * x)); }
__device__ __forceinline__ void p0_mod_slice(const Args& a, LAS unsigned char* lds, int slice, int tid) {
    const int wave = __builtin_amdgcn_readfirstlane(tid >> 6), lane = tid & 63, n = lane & 15, kg = lane >> 4;
    const int kq = wave & 3, mh = wave >> 2, mb0 = mh ? 5 : 0, nmb = mh ? 4 : 5, c0 = slice * 32;
    const float* wada = a.in[I_WADA]; const float* cp = a.in[I_CP]; const float* cs = a.in[I_CS];
    pg8::f32x4 acc[5][2];
#pragma unroll
    for (int i = 0; i < 5; ++i) { acc[i][0] = (pg8::f32x4){0.f, 0.f, 0.f, 0.f}; acc[i][1] = acc[i][0]; }
    for (int ks = 0; ks < 8; ++ks) {
        const int k0 = kq * 256 + ks * 32 + kg * 8;
        bf16x8 bfr[2];
#pragma unroll
        for (int nb = 0; nb < 2; ++nb) { float w[8];
#pragma unroll
            for (int j = 0; j < 8; ++j) w[j] = wada[(size_t)(k0 + j) * MODW + c0 + nb * 16 + n];
            bfr[nb] = pack8((pg8::f32x4){w[0], w[1], w[2], w[3]}, (pg8::f32x4){w[4], w[5], w[6], w[7]}); }
#pragma unroll
        for (int mi = 0; mi < 5; ++mi) {
            if (mi < nmb) {
                const int row = (mb0 + mi) * 16 + n;
                pg8::f32x4 x0 = {0.f, 0.f, 0.f, 0.f}, x1 = x0;
                if (row < NMOD) { const float* cr = (row < NBP ? cp + (size_t)row * D : cs + (size_t)(row - NBP) * D) + k0; x0 = *(const pg8::f32x4*)cr; x1 = *(const pg8::f32x4*)(cr + 4); }
#pragma unroll
                for (int j = 0; j < 4; ++j) { x0[j] = silu_f(x0[j]); x1[j] = silu_f(x1[j]); }
                const bf16x8 af = pack8(x0, x1);
                acc[mi][0] = MFMA16(af, bfr[0], acc[mi][0]); acc[mi][1] = MFMA16(af, bfr[1], acc[mi][1]);
            }
        }
    }
    LAS float* P = (LAS float*)lds;
#pragma unroll
    for (int mi = 0; mi < 5; ++mi) if (mi < nmb) {
#pragma unroll
        for (int nb = 0; nb < 2; ++nb)
#pragma unroll
            for (int i = 0; i < 4; ++i) P[(kq * 144 + (mb0 + mi) * 16 + kg * 4 + i) * 32 + nb * 16 + n] = acc[mi][nb][i];
    }
    __syncthreads();
    float* mod = (float*)(a.ws + WS_MOD); const float* bada = a.in[I_BADA];
    for (int idx = tid; idx < NMOD * 32; idx += NWAVES * 64) { const int row = idx >> 5, col = idx & 31;
        const float v = ((P[(0 * 144 + row) * 32 + col] + P[(1 * 144 + row) * 32 + col]) + (P[(2 * 144 + row) * 32 + col] + P[(3 * 144 + row) * 32 + col])) + bada[c0 + col];
        mod[(size_t)row * MODW + c0 + col] = v; }
    __syncthreads();
}
__device__ __forceinline__ void p0_prologue(const Args& a, LAS unsigned char* lds, int tid, int G) {
    for (int s = blockIdx.x; s < MODW / 32; s += G) p0_mod_slice(a, lds, s, tid);
}
__device__ __forceinline__ void p0_weights(const Args& a, LAS unsigned char* lds, int tid, int G) {
    const int wave = __builtin_amdgcn_readfirstlane(tid >> 6), lane = tid & 63;
    LAS float* scr = (LAS float*)(lds + wave * 16384);
    const int gw = blockIdx.x * NWAVES + wave, NGW = G * NWAVES;
    constexpr int I_1 = (D / 64) * (PROJ / 32), I_2 = (D / 64) * (D / 32), I_3 = (D / 64) * (UPW / 32), I_4 = (FF / 64) * (D / 32), I_5 = 4 * 8;
    constexpr int NITEMS = I_1 + I_2 + I_3 + I_4 + I_5;
    for (int it = gw; it < NITEMS; it += NGW) {
        int r = it;
        if (r < I_1) { p0_transpose_item(a.in[I_WIN], D, PROJ, (bf16*)(a.ws + WS_WIN), scr, r, lane); continue; } r -= I_1;
        if (r < I_2) { p0_transpose_item(a.in[I_WOUT], D, D, (bf16*)(a.ws + WS_WOUT), scr, r, lane); continue; } r -= I_2;
        if (r < I_3) { p0_transpose_item<true>(a.in[I_WUP], D, UPW, (bf16*)(a.ws + WS_WUP), scr, r, lane); continue; } r -= I_3;
        if (r < I_4) { p0_transpose_item(a.in[I_WDN], FF, D, (bf16*)(a.ws + WS_WDN), scr, r, lane); continue; } r -= I_4;
        { const int g = r >> 3; p0_transpose_item(a.in[I_WPOOL] + (size_t)g * 16384, 128, 128, (bf16*)(a.ws + WS_WPOOL) + (size_t)g * 16384, scr, r & 7, lane); }
    }
}
__device__ __forceinline__ const float* x_row(const Args& a, int row) { return row < MP ? a.in[I_XP] + (size_t)row * D : a.in[I_XS] + (size_t)(row - MP) * D; }
__device__ __forceinline__ int mod_row(int row) { return row < MP ? (row >> 11) : NBP + ((row - MP) >> 3); }
__device__ __forceinline__ void p1_norm_in(const Args& a, int gw, int NGW, int lane) {
    const float* mod = (const float*)(a.ws + WS_MOD); const float* g = a.in[I_GPM]; bf16* XN = (bf16*)(a.ws + WS_XN);
    for (int row = gw; row < M; row += NGW) {
        const GAS f32x4* xr = (const GAS f32x4*)x_row(a, row) + lane; const float* md = mod + (size_t)mod_row(row) * MODW;
        f32x4 v[4]; float ss = 0.f;
#pragma unroll
        for (int j = 0; j < 4; ++j) { v[j] = xr[64 * j]; ss += (v[j].x * v[j].x + v[j].y * v[j].y) + (v[j].z * v[j].z + v[j].w * v[j].w); }
        const float rstd = 1.f / sqrtf(wave_sum(ss) * (1.f / D) + EPS);
        GAS v2u* o8 = (GAS v2u*)(XN + (size_t)row * D) + lane;
#pragma unroll
        for (int j = 0; j < 4; ++j) { const int col = 4 * lane + 256 * j;
            const f32x4 gg = *(const f32x4*)(g + col), sh = *(const f32x4*)(md + col), sc = *(const f32x4*)(md + D + col);
            const f32x4 h = v[j] * rstd * gg * (sc + 1.f) + sh;
            v2u w; w.x = pkbf(h.x, h.y); w.y = pkbf(h.z, h.w); o8[64 * j] = w; }
    }
}
__device__ __forceinline__ void p6_norm_mid(const Args& a, int gw, int NGW, int lane) {
    const float* mod = (const float*)(a.ws + WS_MOD); const float* gq = a.in[I_GQM]; const float* gp = a.in[I_GPF];
    const bf16* MO = (const bf16*)(a.ws + WS_MO); bf16* XN = (bf16*)(a.ws + WS_XN);
    for (int row = gw; row < M; row += NGW) {
        const GAS f32x4* xr = (const GAS f32x4*)x_row(a, row) + lane; const float* md = mod + (size_t)mod_row(row) * MODW;
        const GAS v2u* mr = (const GAS v2u*)(MO + (size_t)row * D) + lane;
        f32x4 v[4], mm[4]; float ss = 0.f;
#pragma unroll
        for (int j = 0; j < 4; ++j) { v[j] = xr[64 * j]; const v2u w = mr[64 * j]; mm[j] = (f32x4){bflo(w.x), bfhi(w.x), bflo(w.y), bfhi(w.y)};
            ss += (mm[j].x * mm[j].x + mm[j].y * mm[j].y) + (mm[j].z * mm[j].z + mm[j].w * mm[j].w); }
        const float rstd = 1.f / sqrtf(wave_sum(ss) * (1.f / D) + EPS);
        float s1 = 0.f;
        GAS v2u* x1o = (GAS v2u*)((bf16*)(a.ws + WS_X1) + (size_t)row * D) + lane;
#pragma unroll
        for (int j = 0; j < 4; ++j) { const int col = 4 * lane + 256 * j;
            const f32x4 gg = *(const f32x4*)(gq + col), gt = *(const f32x4*)(md + 2 * D + col);
            v[j] = v[j] + gt * (mm[j] * rstd * gg); { v2u w1; w1.x = pkbf(v[j].x, v[j].y); w1.y = pkbf(v[j].z, v[j].w); x1o[64 * j] = w1; }
            s1 += (v[j].x * v[j].x + v[j].y * v[j].y) + (v[j].z * v[j].z + v[j].w * v[j].w); }
        const float rstd1 = 1.f / sqrtf(wave_sum(s1) * (1.f / D) + EPS);
        GAS v2u* o8 = (GAS v2u*)(XN + (size_t)row * D) + lane;
#pragma unroll
        for (int j = 0; j < 4; ++j) { const int col = 4 * lane + 256 * j;
            const f32x4 gg = *(const f32x4*)(gp + col), sh = *(const f32x4*)(md + 3 * D + col), sc = *(const f32x4*)(md + 4 * D + col);
            const f32x4 h = v[j] * rstd1 * gg * (sc + 1.f) + sh;
            v2u w; w.x = pkbf(h.x, h.y); w.y = pkbf(h.z, h.w); o8[64 * j] = w; }
    }
}
__device__ __forceinline__ void p10_norm_out(const Args& a, int gw, int NGW, int lane) {
    const float* mod = (const float*)(a.ws + WS_MOD); const float* gq = a.in[I_GQF]; const bf16* Fb = (const bf16*)(a.ws + WS_F);
    for (int row = gw; row < M; row += NGW) {
        const float* md = mod + (size_t)mod_row(row) * MODW;
        GAS f32x4* xr = (GAS f32x4*)(a.out + O_Y + (size_t)row * D) + lane; const GAS v2u* fr = (const GAS v2u*)(Fb + (size_t)row * D) + lane;
        const GAS v2u* x1r = (const GAS v2u*)((const bf16*)(a.ws + WS_X1) + (size_t)row * D) + lane;
        f32x4 v[4], mm[4]; float ss = 0.f;
#pragma unroll
        for (int j = 0; j < 4; ++j) { { const v2u w1 = x1r[64 * j]; v[j] = (f32x4){bflo(w1.x), bfhi(w1.x), bflo(w1.y), bfhi(w1.y)}; } const v2u w = fr[64 * j]; mm[j] = (f32x4){bflo(w.x), bfhi(w.x), bflo(w.y), bfhi(w.y)};
            ss += (mm[j].x * mm[j].x + mm[j].y * mm[j].y) + (mm[j].z * mm[j].z + mm[j].w * mm[j].w); }
        const float rstd = 1.f / sqrtf(wave_sum(ss) * (1.f / D) + EPS);
#pragma unroll
        for (int j = 0; j < 4; ++j) { const int col = 4 * lane + 256 * j;
            const f32x4 gg = *(const f32x4*)(gq + col), gt = *(const f32x4*)(md + 5 * D + col);
            xr[64 * j] = v[j] + gt * (mm[j] * rstd * gg); }
    }
}

__device__ __forceinline__ int rel_bucket(int dist) {
    if (dist < 16) return dist;
    int large = 16 + (int)(log((double)dist / 16.0) / log(8.0) * 16.0);
    return large < 31 ? large : 31;
}
__device__ __forceinline__ void build_bias_tables(const Args& a, LAS unsigned char* lds, int tid) {
    LAS float* RT = (LAS float*)(lds + RT_OFF); LAS float* BT = (LAS float*)(lds + BT_OFF); const float* rb = a.in[I_RELB];
    for (int i = tid; i < 4 * 128; i += NWAVES * 64) { const int h = i >> 7, d = i & 127; BT[i] = (rb[rel_bucket(d) * 4 + h] - rb[31 * 4 + h]) * LOG2E; }
    __syncthreads();
    for (int i = tid; i < 4 * RT_N; i += NWAVES * 64) { const int h = i / RT_N, idx = i % RT_N, dist = 447 - idx; RT[i] = (dist >= 0 && dist <= 127) ? BT[h * 128 + dist] : 0.f; }
    __syncthreads();
}
__device__ __forceinline__ float lam_value(const Args& a, int lane) {
    const float p1 = wave_sum(a.in[I_LQ1][lane] * a.in[I_LK1][lane]), p2 = wave_sum(a.in[I_LQ2][lane] * a.in[I_LK2][lane]);
    return expf(p1) - expf(p2) + LAM_INIT;
}
constexpr int SA_OSTR = 132;
__device__ __forceinline__ void sattn_unit(const Args& a, LAS unsigned char* lds, int s, int h, float lam, int tid) {
    const int wave = __builtin_amdgcn_readfirstlane(tid >> 6), lane = tid & 63, n = lane & 15, kg = lane >> 4, qi = n & 7, qc = n >> 3;
    const bf16* Z = (const bf16*)(a.ws + WS_Z); const float* ck = a.in[I_CK]; const float* cv = a.in[I_CV]; const int* pt = (const int*)a.in[I_PT] + s * NPAGES;
    const LAS float* BT = (const LAS float*)(lds + BT_OFF) + h * 128;
    bf16x8 qf[4];
#pragma unroll
    for (int ks = 0; ks < 4; ++ks) { v4u w = {0u, 0u, 0u, 0u};
        if ((ks >> 1) == qc) w = *(const v4u*)(Z + (size_t)(MP + s * TS + qi) * PROJ + 512 + h * 128 + qc * 64 + (ks & 1) * 32 + kg * 8);
        qf[ks] = __builtin_bit_cast(bf16x8, w); }
    pg8::f32x4 o[8];
#pragma unroll
    for (int vb = 0; vb < 8; ++vb) o[vb] = (pg8::f32x4){0.f, 0.f, 0.f, 0.f};
    float mrun = -INFINITY, lrun = 0.f;
    pg8::f32x4 kr[2][4][2], vv[8][2];
#define SA_LOADK(key0_) do { const int kk_ = (key0_); const float* kb_ = ck + ((size_t)(pt[kk_ >> 7] * PAGE + (kk_ & 127)) * 4 + h) * 128; \
        _Pragma("unroll") for (int b2 = 0; b2 < 2; ++b2) _Pragma("unroll") for (int ks = 0; ks < 4; ++ks) { const float* p_ = kb_ + (size_t)(b2 * 16 + n) * 512 + ks * 32 + kg * 8; \
            kr[b2][ks][0] = *(const pg8::f32x4*)p_; kr[b2][ks][1] = *(const pg8::f32x4*)(p_ + 4); } } while (0)
#define SA_LOADV(key0_) do { const int kk_ = (key0_); const float* vb_ = cv + ((size_t)(pt[kk_ >> 7] * PAGE + (kk_ & 127)) * 4 + h) * 128; \
        _Pragma("unroll") for (int j = 0; j < 8; ++j) { const float* p_ = vb_ + (size_t)(16 * (j >> 2) + 4 * kg + (j & 3)) * 512 + 8 * n; vv[j][0] = *(const pg8::f32x4*)p_; vv[j][1] = *(const pg8::f32x4*)(p_ + 4); } } while (0)
    SA_LOADK(wave * 256); SA_LOADV(wave * 256);
    for (int tt = 0; tt < 8; ++tt) {
        const int key0 = wave * 256 + tt * 32;
        pg8::f32x4 sc[2];
#pragma unroll
        for (int b2 = 0; b2 < 2; ++b2) { sc[b2] = (pg8::f32x4){0.f, 0.f, 0.f, 0.f};
#pragma unroll
            for (int ks = 0; ks < 4; ++ks) sc[b2] = MFMA16(pack8(kr[b2][ks][0], kr[b2][ks][1]), qf[ks], sc[b2]); }
        if (tt < 7) SA_LOADK(key0 + 32);
        if (key0 >= PAST - 128) {
#pragma unroll
            for (int b2 = 0; b2 < 2; ++b2)
#pragma unroll
                for (int i = 0; i < 4; ++i) { int dist = PAST + qi - (key0 + b2 * 16 + kg * 4 + i); dist = dist > 127 ? 127 : dist; sc[b2][i] += BT[dist]; }
        }
        float mx = fmaxf(fmaxf(fmaxf(sc[0][0], sc[0][1]), fmaxf(sc[0][2], sc[0][3])), fmaxf(fmaxf(sc[1][0], sc[1][1]), fmaxf(sc[1][2], sc[1][3])));
        mx = fmaxf(mx, __shfl_xor(mx, 16)); mx = fmaxf(mx, __shfl_xor(mx, 32));
        const float mnew = fmaxf(mrun, mx), alpha = __builtin_amdgcn_exp2f(mrun - mnew); mrun = mnew;
        float ps = 0.f;
#pragma unroll
        for (int b2 = 0; b2 < 2; ++b2)
#pragma unroll
            for (int i = 0; i < 4; ++i) { sc[b2][i] = __builtin_amdgcn_exp2f(sc[b2][i] - mnew); ps += sc[b2][i]; }
        lrun = lrun * alpha + ps;
        const bf16x8 pf = pack8(sc[0], sc[1]);
#pragma unroll
        for (int vb = 0; vb < 8; ++vb) { o[vb] = o[vb] * alpha;
            o[vb] = MFMA16(pack8((pg8::f32x4){vv[0][vb >> 2][vb & 3], vv[1][vb >> 2][vb & 3], vv[2][vb >> 2][vb & 3], vv[3][vb >> 2][vb & 3]},
                                 (pg8::f32x4){vv[4][vb >> 2][vb & 3], vv[5][vb >> 2][vb & 3], vv[6][vb >> 2][vb & 3], vv[7][vb >> 2][vb & 3]}), pf, o[vb]); }
        if (tt < 7) SA_LOADV(key0 + 32);
    }
#undef SA_LOADK
#undef SA_LOADV
    if (wave == 0) {
        int l2 = lane; asm volatile("" : "+v"(l2)); const int n = l2 & 15, kg = l2 >> 4, qi = n & 7;
        const bf16* zr = Z + (size_t)(MP + s * TS) * PROJ;
        pg8::f32x4 sc0 = {0.f, 0.f, 0.f, 0.f};
#pragma unroll
        for (int ks = 0; ks < 4; ++ks) { v4u w = {0u, 0u, 0u, 0u};
            if (n < 8) w = *(const v4u*)(zr + (size_t)n * PROJ + 1024 + h * 128 + (ks >> 1) * 64 + (ks & 1) * 32 + kg * 8);
            sc0 = MFMA16(__builtin_bit_cast(bf16x8, w), qf[ks], sc0); }
#pragma unroll
        for (int i = 0; i < 4; ++i) { const int key = kg * 4 + i; const int dd = qi - key; sc0[i] = (key <= qi) ? sc0[i] + BT[dd < 0 ? 0 : dd] : -INFINITY; }
        float mx = fmaxf(fmaxf(sc0[0], sc0[1]), fmaxf(sc0[2], sc0[3]));
        mx = fmaxf(mx, __shfl_xor(mx, 16)); mx = fmaxf(mx, __shfl_xor(mx, 32));
        const float mnew = fmaxf(mrun, mx), alpha = __builtin_amdgcn_exp2f(mrun - mnew); mrun = mnew;
        float ps = 0.f;
#pragma unroll
        for (int i = 0; i < 4; ++i) { sc0[i] = __builtin_amdgcn_exp2f(sc0[i] - mnew); ps += sc0[i]; }
        lrun = lrun * alpha + ps;
        const bf16x8 pf = pack8(sc0, (pg8::f32x4){0.f, 0.f, 0.f, 0.f});
        v4u vk[4];
#pragma unroll
        for (int j = 0; j < 4; ++j) { vk[j] = (v4u){0u, 0u, 0u, 0u}; if (kg < 2) vk[j] = *(const v4u*)(zr + (size_t)(kg * 4 + j) * PROJ + 1536 + h * 128 + 8 * n); }
#pragma unroll
        for (int vb = 0; vb < 8; ++vb) { const int sh = (vb & 1) * 16; v4u w = {0u, 0u, 0u, 0u};
            w.x = ((vk[0][vb >> 1] >> sh) & 0xffffu) | (((vk[1][vb >> 1] >> sh) & 0xffffu) << 16); w.y = ((vk[2][vb >> 1] >> sh) & 0xffffu) | (((vk[3][vb >> 1] >> sh) & 0xffffu) << 16);
            o[vb] = o[vb] * alpha; o[vb] = MFMA16(__builtin_bit_cast(bf16x8, w), pf, o[vb]); }
    }
    lrun += __shfl_xor(lrun, 16); lrun += __shfl_xor(lrun, 32);
    LAS float* OT = (LAS float*)lds; LAS float* ML = (LAS float*)(lds + 8 * 16 * SA_OSTR * 4);
    { int l3 = lane; asm volatile("" : "+v"(l3)); const int n = l3 & 15, kg = l3 >> 4;
#pragma unroll
    for (int i = 0; i < 4; ++i) { LAS float* op_ = OT + (wave * 16 + n) * SA_OSTR + 32 * kg + 8 * i;
        *(LAS pg8::f32x4*)op_ = (pg8::f32x4){o[0][i], o[1][i], o[2][i], o[3][i]}; *(LAS pg8::f32x4*)(op_ + 4) = (pg8::f32x4){o[4][i], o[5][i], o[6][i], o[7][i]}; }
    if (kg == 0) { ML[(wave * 16 + n) * 2] = mrun; ML[(wave * 16 + n) * 2 + 1] = lrun; } }
    __syncthreads();
    {
        const int i = wave; float oc[2][2];
#pragma unroll
        for (int c = 0; c < 2; ++c) { const int nn = c * 8 + i; float mxx = -INFINITY;
#pragma unroll
            for (int w2 = 0; w2 < 8; ++w2) mxx = fmaxf(mxx, ML[(w2 * 16 + nn) * 2]);
            float L = 0.f, A0 = 0.f, A1 = 0.f;
#pragma unroll
            for (int w2 = 0; w2 < 8; ++w2) { const float f = __builtin_amdgcn_exp2f(ML[(w2 * 16 + nn) * 2] - mxx); L += f * ML[(w2 * 16 + nn) * 2 + 1];
                A0 += f * OT[(w2 * 16 + nn) * SA_OSTR + lane]; A1 += f * OT[(w2 * 16 + nn) * SA_OSTR + 64 + lane]; }
            const float rl = 1.f / L; oc[c][0] = A0 * rl; oc[c][1] = A1 * rl; }
        const float r0 = oc[0][0] - lam * oc[1][0], r1 = oc[0][1] - lam * oc[1][1];
        const float rstd = 1.f / sqrtf(wave_sum(r0 * r0 + r1 * r1) * (1.f / 128.f) + EPS);
        const float* gh = a.in[I_GHEAD]; bf16* mix = (bf16*)(a.ws + WS_MIX) + (size_t)(MP + s * TS + i) * D + 512 + h * 128;
        mix[lane] = (bf16)(pkbf(r0 * rstd * gh[lane] * (1.f - LAM_INIT), 0.f) & 0xffffu);
        mix[lane + 64] = (bf16)(pkbf(r1 * rstd * gh[lane + 64] * (1.f - LAM_INIT), 0.f) & 0xffffu);
    }
    __syncthreads();
}
template <int W> __device__ __forceinline__ void pool_window(const float (&e0)[23], const float (&e1)[23], int pos0  , unsigned (&dpk)[8]) {
    float s0 = 0.f, s1 = 0.f;
#pragma unroll
    for (int r = 16 - W; r <= 15; ++r) { s0 += e0[r]; s1 += e1[r]; }
#pragma unroll
    for (int i = 0; i < 8; ++i) {
        if (i > 0) { s0 += e0[15 + i] - e0[15 + i - W]; s1 += e1[15 + i] - e1[15 + i - W]; }
        float cnt = (float)W; if (pos0 >= 0) { const int c = pos0 + i + 1; cnt = (float)(c < W ? c : W); }
        const float rc = 1.f / cnt;
        dpk[i] = pkbf(s0 * rc - e0[15 + i], s1 * rc - e1[15 + i]);
    }
}
constexpr int PD_STR = 136;
__device__ __forceinline__ void pool_item(const Args& a, LAS unsigned char* lds, int item, int tid) {
    int tid_ = tid; asm volatile("" : "+v"(tid_));
    const int wave = __builtin_amdgcn_readfirstlane(tid_ >> 6), lane = tid_ & 63, n = lane & 15, kg = lane >> 4;
    const int tile = item >> 2, g = item & 3, row0 = tile * 64 + wave * 8;
    const bf16* Z = (const bf16*)(a.ws + WS_Z);
    float e0[23], e1[23]; int pos0;
    if (row0 < MP) {
        const int t0 = row0 & (TP - 1); pos0 = t0;
#pragma unroll
        for (int r = 0; r < 23; ++r) { const int t = t0 - 15 + r; unsigned w = 0u;
            if (t >= 0) w = *(const unsigned*)(Z + (size_t)(row0 - 15 + r) * PROJ + g * 128 + 2 * lane);
            e0[r] = bflo(w); e1[r] = bfhi(w); }
    } else {
        const int s = (row0 - MP) >> 3; pos0 = -1; const float* sp = a.in[I_SP] + (size_t)s * 15 * 512 + g * 128 + 2 * lane;
#pragma unroll
        for (int r = 0; r < 15; ++r) { const f32x2 v = *(const f32x2*)(sp + (size_t)r * 512); e0[r] = v.x; e1[r] = v.y; }
#pragma unroll
        for (int r = 15; r < 23; ++r) { const unsigned w = *(const unsigned*)(Z + (size_t)(row0 + r - 15) * PROJ + g * 128 + 2 * lane); e0[r] = bflo(w); e1[r] = bfhi(w); }
        float* ps = a.out + O_PS + (size_t)s * 15 * 512 + g * 128 + 2 * lane;
#pragma unroll
        for (int r = 8; r < 15; ++r) *(f32x2*)(ps + (size_t)(r - 8) * 512) = (f32x2){e0[r], e1[r]};
    }
    unsigned dpk[8];
    if (g == 0) pool_window<2>(e0, e1, pos0, dpk); else if (g == 1) pool_window<4>(e0, e1, pos0, dpk); else if (g == 2) pool_window<8>(e0, e1, pos0, dpk); else pool_window<16>(e0, e1, pos0, dpk);
    LAS bf16* Dt = (LAS bf16*)lds;
#pragma unroll
    for (int i = 0; i < 8; ++i) *(LAS unsigned*)(Dt + (wave * 8 + i) * PD_STR + 2 * lane) = dpk[i];
    __syncthreads();
    const int rb = wave & 3, ch = wave >> 2;
    const bf16* wp = (const bf16*)(a.ws + WS_WPOOL) + (size_t)g * 16384;
    pg8::f32x4 acc[4];
#pragma unroll
    for (int nb = 0; nb < 4; ++nb) acc[nb] = (pg8::f32x4){0.f, 0.f, 0.f, 0.f};
#pragma unroll
    for (int ks = 0; ks < 4; ++ks) {
        const bf16x8 af = *(const LAS bf16x8*)(Dt + (rb * 16 + n) * PD_STR + ks * 32 + kg * 8);
#pragma unroll
        for (int nb = 0; nb < 4; ++nb) { const bf16x8 bf_ = *(const bf16x8*)(wp + (size_t)(ch * 64 + nb * 16 + n) * 128 + ks * 32 + kg * 8); acc[nb] = MFMA16(af, bf_, acc[nb]); }
    }
    const float* psc = a.in[I_PSCALE] + g * 128; bf16* mix = (bf16*)(a.ws + WS_MIX);
#pragma unroll
    for (int nb = 0; nb < 4; ++nb) { const int col = ch * 64 + nb * 16 + n; const float sc = psc[col];
#pragma unroll
        for (int i = 0; i < 4; ++i) mix[(size_t)(tile * 64 + rb * 16 + kg * 4 + i) * D + g * 128 + col] = (bf16)(pkbf(acc[nb][i] * sc, 0.f) & 0xffffu); }
    __syncthreads();
}
__device__ __forceinline__ void p4_combine(const Args& a, int gw, int NGW, int lane) {
    const float lam = lam_value(a, lane); const float* gh = a.in[I_GHEAD];
    const bf16* OB = (const bf16*)(a.ws + WS_OB); bf16* mix = (bf16*)(a.ws + WS_MIX);
    const int h = lane >> 4, vd0 = (lane & 15) * 8;
    const f32x4 g0 = *(const f32x4*)(gh + vd0), g1 = *(const f32x4*)(gh + vd0 + 4);
    for (int row = gw; row < MP; row += NGW) {
        const v4u w0 = *(const v4u*)(OB + (size_t)row * D + h * 256 + vd0), w1 = *(const v4u*)(OB + (size_t)row * D + h * 256 + 128 + vd0);
        float o[8];
        o[0] = bflo(w0.x) - lam * bflo(w1.x); o[1] = bfhi(w0.x) - lam * bfhi(w1.x); o[2] = bflo(w0.y) - lam * bflo(w1.y); o[3] = bfhi(w0.y) - lam * bfhi(w1.y);
        o[4] = bflo(w0.z) - lam * bflo(w1.z); o[5] = bfhi(w0.z) - lam * bfhi(w1.z); o[6] = bflo(w0.w) - lam * bflo(w1.w); o[7] = bfhi(w0.w) - lam * bfhi(w1.w);
        float ss = 0.f;
#pragma unroll
        for (int j = 0; j < 8; ++j) ss += o[j] * o[j];
        ss += __shfl_xor(ss, 1); ss += __shfl_xor(ss, 2); ss += __shfl_xor(ss, 4); ss += __shfl_xor(ss, 8);
        const float r = (1.f - LAM_INIT) / sqrtf(ss * (1.f / 128.f) + EPS);
        v4u w; w.x = pkbf(o[0] * r * g0.x, o[1] * r * g0.y); w.y = pkbf(o[2] * r * g0.z, o[3] * r * g0.w); w.z = pkbf(o[4] * r * g1.x, o[5] * r * g1.y); w.w = pkbf(o[6] * r * g1.z, o[7] * r * g1.w);
        *(v4u*)(mix + (size_t)row * D + 512 + h * 128 + vd0) = w;
    }
}
__device__ __forceinline__ void unpack8(v4u w, float (&f)[8]) { f[0] = bflo(w.x); f[1] = bfhi(w.x); f[2] = bflo(w.y); f[3] = bfhi(w.y); f[4] = bflo(w.z); f[5] = bfhi(w.z); f[6] = bflo(w.w); f[7] = bfhi(w.w); }
__device__ __forceinline__ int static_unit_pm(int nM, int nN, int L) {
    const int nwg = nM * nN; int wgid = L; { const int q = nwg / pg8::NXCD, r = nwg % pg8::NXCD, xcd = wgid % pg8::NXCD, off = wgid / pg8::NXCD; wgid = (xcd < r ? xcd * (q + 1) : r * (q + 1) + (xcd - r) * q) + off; }
    const int nig = pg8::WGM * nN, gid = wgid / nig, fm = gid * pg8::WGM, gsz = (nM - fm) < pg8::WGM ? (nM - fm) : pg8::WGM;
    return fm + ((wgid % nig) % gsz);
}
__device__ __forceinline__ void p8_fixup_panel(const Args& a, int pm, int tid) {
    if ((pm & 7) == 0 || pm >= MP / 256) return;
    const float* UH = (const float*)(a.ws + WS_UH); bf16* ACT = (bf16*)(a.ws + WS_ACT); const float* cw = a.in[I_CONVW]; const float* cb = a.in[I_CONVB];
    constexpr int NCH = FF / 8;
    const float* hp = UH + (size_t)(pm - 1) * 4 * UPW; const float* hc = UH + (size_t)pm * 4 * UPW;
    for (int it = tid; it < 2 * NCH; it += NWAVES * 64) {
        const int r = it / NCH, j0 = (it % NCH) * 8;
        const float* r2 = r == 0 ? hp + 2 * UPW : hp + 3 * UPW;
        const float* r1 = r == 0 ? hp + 3 * UPW : hc;
        const float* r0 = r == 0 ? hc : hc + UPW;
        float res[8];
#pragma unroll
        for (int j = 0; j < 8; ++j) { const int cg = j0 + j, cvv = FF + j0 + j;
            const float g = cb[cg] + cw[cg] * r2[cg] + cw[UPW + cg] * r1[cg] + cw[2 * UPW + cg] * r0[cg];
            const float v = cb[cvv] + cw[cvv] * r2[cvv] + cw[UPW + cvv] * r1[cvv] + cw[2 * UPW + cvv] * r0[cvv];
            res[j] = gelu_tanh(g) * v; }
        v4u w; w.x = pkbf(res[0], res[1]); w.y = pkbf(res[2], res[3]); w.z = pkbf(res[4], res[5]); w.w = pkbf(res[6], res[7]);
        *(v4u*)(ACT + (size_t)(pm * 256 + r) * FF + j0) = w;
    }
}

#ifndef P3_SUB
#define P3_SUB 7
#endif
#ifndef RP_SATTN
#define RP_SATTN 1
#endif
#ifndef RP_PATTN
#define RP_PATTN 1
#endif
#ifndef RP_THIN
#define RP_THIN 1
#endif
#ifndef RP_SMALL
#define RP_SMALL 1
#endif
#ifndef RP_G2
#define RP_G2 1
#endif
#ifndef RP_G5
#define RP_G5 1
#endif
#ifndef RP_G9
#define RP_G9 1
#endif
#ifndef RP_G7
#define RP_G7 1
#endif
#ifndef RP_P0
#define RP_P0 1
#endif
constexpr int N_PHASES = 11;
__global__ void __launch_bounds__(NWAVES * 64, 2) fwd_kernel(Args args) {
    extern __shared__ __attribute__((aligned(16))) unsigned char lds_raw[];
    LAS unsigned char* lds = (LAS unsigned char*)lds_raw;
    const int G = gridDim.x, bx = blockIdx.x, vcu = (G % 8 == 0) ? (bx % 8) * (G / 8) + bx / 8 : bx;
    const int NGW = G * NWAVES;
#define IDS() int tid = threadIdx.x; asm volatile("" : "+v"(tid)); const int lane = tid & 63, wave = __builtin_amdgcn_readfirstlane(tid >> 6), gw = bx * NWAVES + wave; (void)lane; (void)wave; (void)gw
    for (int u = threadIdx.x; u < (LDS_BYTES - LDSCTL_OFF) / 4; u += NWAVES * 64) ((LAS unsigned*)(lds + LDSCTL_OFF))[u] = 0u;
    __syncthreads();
    volatile LAS unsigned* MISC = (volatile LAS unsigned*)(lds + MISC_OFF);
    unsigned* ctl = (unsigned*)(args.ws + WS_CTL);
    const bool use_bar = (args.ph_hi - args.ph_lo) > 1;
    XcdBarrier bar; bar.bar = ctl + CW_BAR; bar.x = 0; bar.st = nullptr;
    if (use_bar) bar = xcd_barrier_post(ctl + CW_BAR, MISC + 8);
    const int lo = args.ph_lo, hi = args.ph_hi;
#ifndef PH_MASK
#define PH_MASK 0xFFFF
#endif
#define IN(k) (((PH_MASK >> (k)) & 1) && lo <= (k) && (k) < hi)
#ifndef RP_BAR
#define RP_BAR 1
#endif
#define SEAM(k) do { if (IN(k) && IN((k) + 1)) { for (int rb_ = 0; rb_ < RP_BAR; ++rb_) xcd_barrier(bar); } } while (0)
#define WSP(off) ((bf16*)(args.ws + (off)))
#define ST_ROWT(t) (((((t) & 7) >> 2) << 3) + ((((t) & 255) >> 3) & 7))
#define ST_COLT(t) ((((t) >> 8) << 4) + ((((t) & 7) & 3) << 2) + ((((t) & 255) >> 3) >> 3))

    if (IN(0)) { IDS(); for (int rp = 0; rp < RP_P0; ++rp) p0_prologue(args, lds, tid, G); } SEAM(0);
    if (IN(1)) { IDS(); p0_weights(args, lds, tid, G); for (int rp = 0; rp < RP_THIN; ++rp) p1_norm_in(args, gw, NGW, lane); } SEAM(1);
    if (IN(2)) {
        pg8::Gemm g{WSP(WS_XN), WSP(WS_WIN), MP, PROJ, D}; pg8::StaticOrder S; S.init(MP, PROJ, G, bx);
        EpiZ E{WSP(WS_Z), args.out};
        for (int rp = 0; rp < RP_G2; ++rp) pg8::gemm_phase<EpiZ, pg8::StaticOrder, true, true>(lds, g, S, E);
        { IDS(); SEpiZ SE{WSP(WS_Z), args.out};
          for (int rp = 0; rp < RP_SMALL; ++rp) for (int t = bx; t < (MS / 128) * (PROJ / 64); t += G) gemm_small_tile<SEpiZ, 2>(lds, WSP(WS_XN), WSP(WS_WIN), D, MP + ((t >> 3) & 7) * 128, (4 * (t & 7) + ((t & 255) >> 6)) * 64, tid, SE); }
    } SEAM(2);
    if (IN(3)) {
        { IDS(); build_bias_tables(args, lds, tid); }
        if ((P3_SUB & 2) && (vcu & 1)) { IDS(); const float lam = lam_value(args, lane); for (int rp = 0; rp < RP_SATTN; ++rp) for (int u = vcu; u < NBS * 4; u += G) sattn_unit(args, lds, u >> 2, u & 3, lam, tid); }
        {
            const int bh = vcu >> 3, b = bh >> 2, h = bh & 3, c = vcu & 1, vh = (vcu >> 1) & 1, hs = (vcu >> 2) & 1;
            if ((P3_SUB & 1) && vcu < 256) {
                for (int i_ = 0; i_ < 4 * RP_PATTN; ++i_) { const int i = i_ & 3;
                    const int qb = hs ? ((i == 0) ? 2 : (i == 1) ? 5 : (i == 2) ? 3 : 4) : ((i == 0) ? 0 : (i == 1) ? 7 : (i == 2) ? 1 : 6);
                    attn_body::attn_unit<8>((long)b * TP, 512 + h * 128 + c * 64, 1024 + h * 128 + c * 64, 1536 + h * 128 + vh * 64, h * 256 + c * 128 + vh * 64, qb,
                                            (const attn_body::bf16*)(args.ws + WS_Z), (attn_body::bf16*)(args.ws + WS_OB), (char*)lds_raw, (attn_body::lds_cfptr)(lds + RT_OFF) + h * RT_N);
                }
            }
        }
        if ((P3_SUB & 2) && !(vcu & 1)) { IDS(); const float lam = lam_value(args, lane); for (int rp = 0; rp < RP_SATTN; ++rp) for (int u = vcu; u < NBS * 4; u += G) sattn_unit(args, lds, u >> 2, u & 3, lam, tid); }
        if (P3_SUB & 4) { IDS(); for (int rp = 0; rp < RP_THIN; ++rp) for (int it = vcu; it < (M / 64) * 4; it += G) pool_item(args, lds, it, tid); }
    } SEAM(3);
    if (IN(4)) { IDS(); for (int rp = 0; rp < RP_THIN; ++rp) p4_combine(args, gw, NGW, lane); } SEAM(4);
    if (IN(5)) {
        pg8::Gemm g{WSP(WS_MIX), WSP(WS_WOUT), MP, D, D}; pg8::StaticOrder S; S.init(MP, D, G, bx);
        EpiPlain E{WSP(WS_MO), D};
        for (int rp = 0; rp < RP_G5; ++rp) pg8::gemm_phase<EpiPlain, pg8::StaticOrder, true, true>(lds, g, S, E);
        { IDS(); SEpiPlain SE{WSP(WS_MO), D};
          for (int rp = 0; rp < RP_SMALL; ++rp) for (int t = bx; t < (MS / 64) * (D / 64); t += G) gemm_small_tile(lds, WSP(WS_MIX), WSP(WS_WOUT), D, MP + ST_ROWT(t) * 64, ST_COLT(t) * 64, tid, SE); }
    } SEAM(5);
    if (IN(6)) { IDS(); for (int rp = 0; rp < RP_THIN; ++rp) p6_norm_mid(args, gw, NGW, lane); } SEAM(6);
    if (IN(7)) {
        pg8::Gemm g{WSP(WS_XN), WSP(WS_WUP), M, UPW, D}; pg8::StaticOrder S; S.init(MP, UPW, G, bx);
        EpiConvGlu E{WSP(WS_ACT), (float*)(args.ws + WS_UH), args.out, args.in[I_CONVW], args.in[I_CONVB], lds + RING_BYTES + 512};
        for (int rp = 0; rp < RP_G7; ++rp) pg8::gemm_phase<EpiConvGlu, pg8::StaticOrder, true, true>(lds, g, S, E);
        { SampleOrder SS{bx, (MP / 256) * (UPW / 256) - (((MP / 256) * (UPW / 256)) / G) * G};
          EpiConvGluS ES{WSP(WS_ACT), args.out, args.in[I_CONVW], args.in[I_CONVB], args.in[I_SC], lds + RING_BYTES + 512};
          pg8::gemm_phase<EpiConvGluS, SampleOrder, true, true>(lds, g, SS, ES); }
    } SEAM(7);
    if (IN(9)) {
        pg8::Gemm g{WSP(WS_ACT), WSP(WS_WDN), MP, D, FF}; pg8::StaticOrder S; S.init(MP, D, G, bx);
        { IDS();
          for (int i = 0; i * G + bx < (MP / 256) * (D / 256); ++i) p8_fixup_panel(args, static_unit_pm(MP / 256, D / 256, i * G + bx), tid);
          asm volatile("s_waitcnt vmcnt(0)" ::: "memory"); __syncthreads(); }
        EpiPlain E{WSP(WS_F), D};
        for (int rp = 0; rp < RP_G9; ++rp) pg8::gemm_phase<EpiPlain, pg8::StaticOrder, true, true>(lds, g, S, E);
        { IDS(); SEpiPlain SE{WSP(WS_F), D};
          for (int rp = 0; rp < RP_SMALL; ++rp) for (int t = bx; t < (MS / 64) * (D / 64); t += G) gemm_small_tile(lds, WSP(WS_ACT), WSP(WS_WDN), FF, MP + ST_ROWT(t) * 64, ST_COLT(t) * 64, tid, SE); }
    } SEAM(9);
    if (IN(10)) { IDS(); p10_norm_out(args, gw, NGW, lane); }
#undef IN
#undef SEAM
}

#ifndef MK_N_LAUNCHES
#define MK_N_LAUNCHES 1
#endif
static_assert((size_t)(CW_BAR + XCD_BAR_WORDS) * 4 <= CTL_ZERO_BYTES, "the per-call memset covers every barrier word");
extern "C" void kernel_launch(void* const* d_in, const int* in_sizes, int n_in, void* d_out, int out_size, void* d_ws, size_t ws_size, hipStream_t stream) {
    static int grid = 0;
    if (grid == 0) {
        if (n_in != 29 || (size_t)out_size != O_END || ws_size < WS_END) { fprintf(stderr, "kernel_launch: unexpected shapes (n_in %d, out %d, ws %zu); nothing launched\n", n_in, out_size, ws_size); grid = -1; return; }
        int dev = 0, cus = 0, per_cu = 0;
        if (hipGetDevice(&dev) != hipSuccess || hipDeviceGetAttribute(&cus, hipDeviceAttributeMultiprocessorCount, dev) != hipSuccess) { grid = -1; return; }
        if (hipFuncSetAttribute((const void*)fwd_kernel, hipFuncAttributeMaxDynamicSharedMemorySize, LDS_BYTES) != hipSuccess) { fprintf(stderr, "kernel_launch: hipFuncSetAttribute failed\n"); grid = -1; return; }
        if (hipOccupancyMaxActiveBlocksPerMultiprocessor(&per_cu, (const void*)fwd_kernel, NWAVES * 64, LDS_BYTES) != hipSuccess || per_cu < 1) { fprintf(stderr, "kernel_launch: occupancy query reports %d workgroups per CU\n", per_cu); }
        (void)hipGetLastError();
        grid = cus;
        if (grid != 256) fprintf(stderr, "kernel_launch: %d CUs (expected 256)\n", grid);
    }
    if (grid < 0) return;
    (void)hipMemsetAsync((char*)d_ws + WS_CTL, 0, CTL_ZERO_BYTES, stream);
    Args a{};
    for (int i = 0; i < 29; ++i) a.in[i] = (const float*)d_in[i];
    a.out = (float*)d_out; a.ws = (unsigned char*)d_ws;
#if MK_N_LAUNCHES == 1
    a.ph_lo = 0; a.ph_hi = N_PHASES;
    hipLaunchKernelGGL(fwd_kernel, dim3(grid), dim3(NWAVES * 64), LDS_BYTES, stream, a);
#else
    for (int p = 0; p < N_PHASES; ++p) { a.ph_lo = p; a.ph_hi = p + 1; hipLaunchKernelGGL(fwd_kernel, dim3(grid), dim3(NWAVES * 64), LDS_BYTES, stream, a); }
#endif
}
```

```cpp
#include <hip/hip_runtime.h>
#include <hip/hip_bf16.h>
#include <cstdio>
#include <cstdint>
#include <cmath>
namespace pg8 {
#define PG8_LAS __attribute__((address_space(3)))
typedef unsigned short bf16_t;
typedef short bf16x8 __attribute__((ext_vector_type(8)));
typedef float f32x4 __attribute__((ext_vector_type(4)));
typedef unsigned u32x4 __attribute__((ext_vector_type(4)));
constexpr int BM = 256, BK = 64, HALF = 128, HTB = HALF * BK * 2  , STAGE_BYTES = 8 * HTB, NXCD = 8, WGM = 8;

__host__ __device__ __forceinline__ int lds_byte(int r, int c) { const int st = (r >> 4) * 2 + (c >> 5), rr = r & 15, cc = c & 31, ob = rr * 64 + cc * 2; return st * 1024 + (ob ^ (((ob >> 9) & 1) << 5)); }
__host__ __device__ __forceinline__ void stage_rc(int b, int& R, int& C) { const int st = b / 1024, sb = b % 1024, swz = sb ^ (((sb >> 9) & 1) << 5); R = (st >> 1) * 16 + swz / 64; C = (st & 1) * 32 + (swz % 64) / 2; }
__host__ __device__ __forceinline__ int perm32(int rho) { const int n = rho >> 4, i = rho & 15; return 8 * (i >> 2) + 4 * n + (i & 3); }

struct Unit { int pm, pn; };
struct Gemm { const bf16_t* A; const bf16_t* Bt; int M, N, K; };

struct StaticOrder {
    int nM, nN, nwg, G, c;
    __host__ __device__ void init(int M, int N, int G_, int c_) { nM = M / BM; nN = N / BM; nwg = nM * nN; G = G_; c = c_; }
    __host__ __device__ bool next(int i, Unit& u) const {
        const long L = (long)i * G + c; if (L >= nwg) return false;
        int wgid = (int)L; { const int q = nwg / NXCD, r = nwg % NXCD, xcd = wgid % NXCD, off = wgid / NXCD; wgid = (xcd < r ? xcd * (q + 1) : r * (q + 1) + (xcd - r) * q) + off; }
        const int nig = WGM * nN, gid = wgid / nig, fm = gid * WGM, gsz = (nM - fm) < WGM ? (nM - fm) : WGM;
        u.pm = fm + ((wgid % nig) % gsz); u.pn = (wgid % nig) / gsz; return true;
    }
    __device__ __forceinline__ void a_ready(const Unit&) const {}
    __device__ __forceinline__ void done(const Unit&) const {}
};

__device__ __forceinline__ unsigned cvt_pk_bf16(float lo, float hi) { unsigned r; asm volatile("v_cvt_pk_bf16_f32 %0, %1, %2" : "=v"(r) : "v"(lo), "v"(hi)); return r; }
typedef float f32x2 __attribute__((ext_vector_type(2)));
__device__ __forceinline__ f32x2 gelu_pk(f32x2 v) {
    const f32x2 av = __builtin_elementwise_abs(v), d = av * 0.2316418882f + 1.0f;
    f32x2 t; t.x = __builtin_amdgcn_rcpf(d.x); t.y = __builtin_amdgcn_rcpf(d.y);
    f32x2 q = t * 0.5307027145f + (-0.7265760135f); q = q * t + 0.7107068705f; q = q * t + (-0.142248368f); q = q * t + 0.127414796f; q = q * t;
    const f32x2 s = (v * v) * (-0.72134752044f);
    f32x2 e; e.x = __builtin_amdgcn_exp2f(s.x); e.y = __builtin_amdgcn_exp2f(s.y);
    const f32x2 m = v * (q * e), r = v - m;
    f32x2 o; o.x = v.x < 0.f ? m.x : r.x; o.y = v.y < 0.f ? m.y : r.y; return o;
}

template <int ACT  > struct EpiBf16 {
    static constexpr bool PERM = true, AFTER_DRAIN = false; static_assert(ACT == 0 || ACT == 1, "EpiBf16: ACT is 0 (none) or 1 (gelu_pk)");
    bf16_t* O; int ldc; const float* bias; int split_cols; size_t split_stride; float scale0;
    __device__ __forceinline__ void operator()(const f32x4 (&acc)[2][2][4][2], const Unit& u, int wr, int wc, int fr, int fq) const {
        const int row0 = u.pm * BM + wr * 64 + fr; int colt = u.pn * BM; bf16_t* base = O;
        float sc = 1.f; if (split_cols) { const int t = colt / split_cols; base += (size_t)t * split_stride; colt -= t * split_cols; if (t == 0) sc = scale0; }
        const int col0 = colt + wc * 32 + 8 * fq, bcol0 = u.pn * BM + wc * 32 + 8 * fq;
        f32x4 bv[2][2];
#pragma unroll
        for (int bj = 0; bj < 2; ++bj)
#pragma unroll
            for (int n = 0; n < 2; ++n) bv[bj][n] = bias ? *(const f32x4*)(bias + bcol0 + bj * HALF + 4 * n) : (f32x4){0.f, 0.f, 0.f, 0.f};
#pragma unroll
        for (int ai = 0; ai < 2; ++ai)
#pragma unroll
            for (int m = 0; m < 4; ++m) { bf16_t* rowp = base + (size_t)(row0 + ai * HALF + m * 16) * ldc + col0;
#pragma unroll
                for (int bj = 0; bj < 2; ++bj) { f32x4 v0 = acc[ai][bj][m][0] + bv[bj][0], v1 = acc[ai][bj][m][1] + bv[bj][1];
                    if (ACT == 1) { f32x2 a = gelu_pk((f32x2){v0[0], v0[1]}), b = gelu_pk((f32x2){v0[2], v0[3]}), c = gelu_pk((f32x2){v1[0], v1[1]}), d = gelu_pk((f32x2){v1[2], v1[3]});
                        v0 = (f32x4){a.x, a.y, b.x, b.y}; v1 = (f32x4){c.x, c.y, d.x, d.y}; }
                    v0 = v0 * sc; v1 = v1 * sc; u32x4 w; w.x = cvt_pk_bf16(v0[0], v0[1]); w.y = cvt_pk_bf16(v0[2], v0[3]); w.z = cvt_pk_bf16(v1[0], v1[1]); w.w = cvt_pk_bf16(v1[2], v1[3]);
                    *(u32x4*)(rowp + bj * HALF) = w; } }
    }
};
template <class Epi, class Sched, bool ALIGN_EPI = false, bool SP2 = false>
__device__ __forceinline__ void gemm_phase(PG8_LAS unsigned char* lds, const Gemm g, const Sched& S, const Epi& E) {
    const int tid = threadIdx.x, wid = __builtin_amdgcn_readfirstlane(tid >> 6), lane = tid & 63, wr = wid >> 2, wc = wid & 3, fr = lane & 15, fq = lane >> 4;
    const int K = g.K, nt = K / BK;
    unsigned voffA[2], voffB[2];
#pragma unroll
    for (int i = 0; i < 2; ++i) { int R, C; stage_rc(tid * 16 + i * 8192, R, C); const int Rb = Epi::PERM ? ((R & ~31) + perm32(R & 31)) : R;
        voffA[i] = (unsigned)(R * K + C) * 2u; voffB[i] = (unsigned)(Rb * K + C) * 2u; }
    const size_t kstep = (size_t)(BK * 2);
    const size_t hstep = (size_t)HALF * K * 2;
    const size_t tstep = 2 * hstep;
    const unsigned ldsw = (unsigned)wid * 1024u;
    const int aoff = lds_byte(wr * 64 + fr, fq * 8), boff = lds_byte(wc * 32 + fr, fq * 8);
#define PG8_SA(b, h) (((b) * 2 + (h)) * HTB)
#define PG8_SB(b, h) ((4 + (b) * 2 + (h)) * HTB)
#define PG8_STAGE(bufoff, gbase, voff) do { _Pragma("unroll") for (int _i = 0; _i < 2; ++_i) \
        __builtin_amdgcn_global_load_lds((const unsigned*)((const char*)(gbase) + (voff)[_i]), (PG8_LAS unsigned*)(lds + (bufoff) + ldsw + _i * 8192), 16, 0, 0); } while (0)
#define PG8_LDA(dst, b, h) do { _Pragma("unroll") for (int m = 0; m < 4; ++m) _Pragma("unroll") for (int k = 0; k < 2; ++k) dst[m][k] = *(const PG8_LAS bf16x8*)(lds + PG8_SA(b, h) + aoff + m * 2048 + k * 1024); } while (0)
#define PG8_LDB(dst, b, h) do { _Pragma("unroll") for (int n = 0; n < 2; ++n) _Pragma("unroll") for (int k = 0; k < 2; ++k) dst[n][k] = *(const PG8_LAS bf16x8*)(lds + PG8_SB(b, h) + boff + n * 2048 + k * 1024); } while (0)
#define PG8_MMA(ai, bj, At, Bt) do { __builtin_amdgcn_s_setprio(1); _Pragma("unroll") for (int m = 0; m < 4; ++m) _Pragma("unroll") for (int n = 0; n < 2; ++n) _Pragma("unroll") for (int k = 0; k < 2; ++k) \
        acc[ai][bj][m][n] = __builtin_amdgcn_mfma_f32_16x16x32_bf16(Bt[n][k], At[m][k], acc[ai][bj][m][n], 0, 0, 0); __builtin_amdgcn_s_setprio(0); } while (0)
#define PG8_WAIT_V(n) asm volatile("s_waitcnt vmcnt(" #n ")" ::: "memory")
#define PG8_WAIT_L(n) asm volatile("s_waitcnt lgkmcnt(" #n ")" ::: "memory")
#define PG8_BAR __builtin_amdgcn_s_barrier()
#define PG8_SCHED __builtin_amdgcn_sched_barrier(0)
    Unit cur, nxt; int ui = 0;
    if (!S.next(0, cur)) return;
    f32x4 acc[2][2][4][2];
#pragma unroll
    for (int a = 0; a < 2; ++a)
#pragma unroll
        for (int b = 0; b < 2; ++b)
#pragma unroll
            for (int m = 0; m < 4; ++m)
#pragma unroll
                for (int n = 0; n < 2; ++n) acc[a][b][m][n] = (f32x4){0.f, 0.f, 0.f, 0.f};
    bf16x8 At[4][2], B0[2][2], B1[2][2];
    const char* cA = (const char*)g.A + (size_t)cur.pm * tstep; const char* cB = (const char*)g.Bt + (size_t)cur.pn * tstep;
    S.a_ready(cur);
    if constexpr (SP2) {
        PG8_STAGE(PG8_SB(0, 0), cB, voffB); PG8_STAGE(PG8_SB(0, 1), cB + hstep, voffB); PG8_STAGE(PG8_SA(0, 0), cA, voffA); PG8_STAGE(PG8_SA(0, 1), cA + hstep, voffA);
        if (wr == 1) PG8_BAR;
        PG8_WAIT_V(2); PG8_BAR;
        PG8_STAGE(PG8_SB(1, 0), cB + kstep, voffB); PG8_STAGE(PG8_SA(1, 0), cA + kstep, voffA); PG8_STAGE(PG8_SB(1, 1), cB + hstep + kstep, voffB);
        PG8_WAIT_V(6); PG8_BAR;
    } else {
        PG8_STAGE(PG8_SB(0, 0), cB, voffB); PG8_STAGE(PG8_SA(0, 0), cA, voffA); PG8_STAGE(PG8_SB(0, 1), cB + hstep, voffB); PG8_STAGE(PG8_SA(0, 1), cA + hstep, voffA);
        if (wr == 1) PG8_BAR;
        PG8_WAIT_V(4); PG8_BAR;
        PG8_STAGE(PG8_SB(1, 0), cB + kstep, voffB); PG8_STAGE(PG8_SA(1, 0), cA + kstep, voffA); PG8_STAGE(PG8_SB(1, 1), cB + hstep + kstep, voffB);
        PG8_WAIT_V(6); PG8_BAR;
    }
    for (;;) {
        const bool has_next = S.next(ui + 1, nxt);
        const char* nA = has_next ? (const char*)g.A + (size_t)nxt.pm * tstep : cA; const char* nB = has_next ? (const char*)g.Bt + (size_t)nxt.pn * tstep : cB;
        for (int t = 0; t < nt; t += 2) {
            const bool last = (t == nt - 2);
            const char* a1 = cA + (size_t)(t + 1) * kstep;
            const char* a2 = last ? nA : cA + (size_t)(t + 2) * kstep; const char* b2 = last ? nB : cB + (size_t)(t + 2) * kstep;
            const char* a3 = a2 + kstep; const char* b3 = b2 + kstep;
            if (last && has_next) S.a_ready(nxt);
            if constexpr (SP2) {
            PG8_LDB(B0, 0, 0); PG8_LDB(B1, 0, 1); PG8_SCHED; PG8_LDA(At, 0, 0); PG8_STAGE(PG8_SA(1, 1), a1 + hstep, voffA);
            PG8_WAIT_V(8); PG8_WAIT_L(0); PG8_BAR; PG8_MMA(0, 0, At, B0); PG8_MMA(0, 1, At, B1); PG8_BAR; PG8_SCHED;
            PG8_LDA(At, 0, 1); PG8_STAGE(PG8_SB(0, 0), b2, voffB); PG8_STAGE(PG8_SB(0, 1), b2 + hstep, voffB); PG8_STAGE(PG8_SA(0, 0), a2, voffA);
            PG8_WAIT_V(8); PG8_WAIT_L(0); PG8_BAR; PG8_MMA(1, 0, At, B0); PG8_MMA(1, 1, At, B1); PG8_BAR; PG8_SCHED;
            PG8_LDB(B0, 1, 0); PG8_LDB(B1, 1, 1); PG8_SCHED; PG8_LDA(At, 1, 0); PG8_STAGE(PG8_SA(0, 1), a2 + hstep, voffA);
            PG8_WAIT_V(8); PG8_WAIT_L(0); PG8_BAR; PG8_MMA(0, 0, At, B0); PG8_MMA(0, 1, At, B1); PG8_BAR; PG8_SCHED;
            PG8_LDA(At, 1, 1); PG8_STAGE(PG8_SB(1, 0), b3, voffB); PG8_STAGE(PG8_SB(1, 1), b3 + hstep, voffB); PG8_STAGE(PG8_SA(1, 0), a3, voffA);
            PG8_WAIT_V(8); PG8_WAIT_L(0); PG8_BAR; PG8_MMA(1, 0, At, B0); PG8_MMA(1, 1, At, B1); PG8_BAR; PG8_SCHED;
            } else {
            PG8_LDB(B0, 0, 0); PG8_SCHED; PG8_LDA(At, 0, 0); PG8_STAGE(PG8_SA(1, 1), a1 + hstep, voffA);
            PG8_WAIT_L(8); PG8_BAR; PG8_WAIT_L(0); PG8_MMA(0, 0, At, B0); PG8_BAR; PG8_SCHED;
            PG8_LDB(B1, 0, 1); PG8_STAGE(PG8_SB(0, 0), b2, voffB);
            PG8_BAR; PG8_WAIT_L(0); PG8_MMA(0, 1, At, B1); PG8_BAR;
            PG8_LDA(At, 0, 1); PG8_STAGE(PG8_SA(0, 0), a2, voffA);
            PG8_BAR; PG8_WAIT_L(0); PG8_MMA(1, 0, At, B0); PG8_BAR; PG8_SCHED;
            PG8_STAGE(PG8_SB(0, 1), b2 + hstep, voffB);
            PG8_WAIT_V(6); PG8_BAR; PG8_MMA(1, 1, At, B1); PG8_BAR;
            PG8_LDB(B0, 1, 0); PG8_SCHED; PG8_LDA(At, 1, 0); PG8_STAGE(PG8_SA(0, 1), a2 + hstep, voffA);
            PG8_WAIT_L(8); PG8_BAR; PG8_WAIT_L(0); PG8_MMA(0, 0, At, B0); PG8_BAR; PG8_SCHED;
            PG8_LDB(B1, 1, 1); PG8_STAGE(PG8_SB(1, 0), b3, voffB);
            PG8_BAR; PG8_WAIT_L(0); PG8_MMA(0, 1, At, B1); PG8_BAR;
            PG8_LDA(At, 1, 1); PG8_STAGE(PG8_SA(1, 0), a3, voffA);
            PG8_BAR; PG8_WAIT_L(0); PG8_MMA(1, 0, At, B0); PG8_BAR; PG8_SCHED;
            PG8_STAGE(PG8_SB(1, 1), b3 + hstep, voffB);
            PG8_WAIT_V(6); PG8_BAR; PG8_MMA(1, 1, At, B1); PG8_BAR;
            }
        }
        if constexpr (ALIGN_EPI) { if (wr == 0) PG8_BAR; }
        if constexpr (!Epi::AFTER_DRAIN) { E(acc, cur, wr, wc, fr, fq); S.done(cur); }
        if (!has_next) break;
#pragma unroll
        for (int a = 0; a < 2; ++a)
#pragma unroll
            for (int b = 0; b < 2; ++b)
#pragma unroll
                for (int m = 0; m < 4; ++m)
#pragma unroll
                    for (int n = 0; n < 2; ++n) acc[a][b][m][n] = (f32x4){0.f, 0.f, 0.f, 0.f};
        cur = nxt; cA = nA; cB = nB; ++ui;
        if constexpr (ALIGN_EPI) { if (wr == 1) PG8_BAR; }
    }
    PG8_WAIT_V(0);
    if constexpr (!ALIGN_EPI) { if (wr == 0) PG8_BAR; }
    PG8_BAR;
    if constexpr (Epi::AFTER_DRAIN) { E.fused(acc, cur, wr, wc, fr, fq, lds, wid, lane); S.done(cur); }
#undef PG8_SA
#undef PG8_SB
#undef PG8_STAGE
#undef PG8_LDA
#undef PG8_LDB
#undef PG8_MMA
#undef PG8_WAIT_V
#undef PG8_WAIT_L
#undef PG8_BAR
#undef PG8_SCHED
}
}
constexpr int D = 1024, NBP = 8, TP = 2048, NBS = 128, TS = 8;
constexpr int MP = NBP * TP, MS = NBS * TS, M = MP + MS;
constexpr int PROJ = 2048, FF = 2816, UPW = 2 * FF, MODW = 6 * D, NMOD = NBP + NBS;
constexpr int PAGE = 128, NPAGES = 16, PAST = 2048;
constexpr float EPS = 1e-6f, LAM_INIT = 0.2f, LOG2E = 1.4426950408889634f;
constexpr float QSCALE = 0.125f * LOG2E;
constexpr size_t O_Y = 0, O_KP = (size_t)M * D, O_VP = O_KP + (size_t)MP * 512, O_PP = O_VP + (size_t)MP * 512, O_CP = O_PP + (size_t)NBP * 15 * 512,
                 O_KS = O_CP + (size_t)NBP * 2 * UPW, O_VS = O_KS + (size_t)MS * 512, O_PS = O_VS + (size_t)MS * 512, O_CS = O_PS + (size_t)NBS * 15 * 512, O_END = O_CS + (size_t)NBS * 2 * UPW;
static_assert(O_END == 38227968, "output size");
constexpr size_t MiB = 1u << 20;
constexpr size_t WS_CTL = 0, CTL_ZERO_BYTES = 32768;
constexpr size_t WS_MOD = 1 * MiB, WS_WIN = 5 * MiB, WS_WOUT = 9 * MiB, WS_WUP = 11 * MiB, WS_WDN = 22 * MiB, WS_WPOOL = 28 * MiB;
constexpr size_t WS_XN = 32 * MiB, WS_Z = 66 * MiB, WS_OB = 134 * MiB, WS_MIX = 166 * MiB, WS_MO = 200 * MiB, WS_U = 234 * MiB, WS_ACT = 421 * MiB, WS_F = 515 * MiB, WS_X1 = 549 * MiB, WS_UH = 583 * MiB, WS_END = 590 * MiB;
static_assert(WS_MOD + (size_t)NMOD * MODW * 4 <= WS_WIN && WS_WUP + (size_t)UPW * D * 2 <= WS_WDN && WS_WDN + (size_t)D * FF * 2 <= WS_WPOOL, "ws map 1");
static_assert(WS_XN + (size_t)M * D * 2 <= WS_Z && WS_Z + (size_t)M * PROJ * 2 <= WS_OB && WS_OB + (size_t)MP * D * 2 <= WS_MIX && WS_MIX + (size_t)M * D * 2 <= WS_MO && WS_MO + (size_t)M * D * 2 <= WS_U, "ws map 2");
static_assert(WS_U + (size_t)M * UPW * 2 <= WS_ACT && WS_ACT + (size_t)M * FF * 2 <= WS_F && WS_F + (size_t)M * D * 2 <= WS_X1 && WS_X1 + (size_t)M * D * 2 <= WS_UH && WS_UH + (size_t)(MP / 256) * 4 * UPW * 4 <= WS_END, "ws map 3");
constexpr int CW_BAR = 4096;
constexpr int RING_BYTES = 131072, LDSCTL_OFF = RING_BYTES, MISC_OFF = LDSCTL_OFF + 320, LDS_BYTES = 147456;
constexpr int RT_OFF = 98304, RT_N = 704, BT_OFF = RT_OFF + 4 * RT_N * 4;
static_assert(BT_OFF + 4 * 128 * 4 <= RING_BYTES, "bias tables inside the ring region");
constexpr int NWAVES = 8;

#include <hip/hip_bf16.h>
#include <cmath>
namespace attn_body {
using bf16=__hip_bfloat16;
using bf16x8=__attribute__((ext_vector_type(8)))short;
using s16x4=__attribute__((ext_vector_type(4)))short;
using f32x16=__attribute__((ext_vector_type(16)))float;
using u32x4=__attribute__((ext_vector_type(4)))unsigned;
constexpr int SEQ=2048,D=64,ZP=2048,OP=1024;
constexpr int NW=8,QBLK=32,QB=QBLK*NW,KVBLK=64,NQB=SEQ/QB;
constexpr int ATTN_UNIT_ROWS=QB;
__device__ __forceinline__ int crow(int r,int hi){return (r&3)+8*(r>>2)+4*hi;}
#define SBAR() __builtin_amdgcn_sched_barrier(0)
typedef __attribute__((address_space(3))) const float* lds_cfptr;
__device__ __forceinline__ void cmask(f32x16&p0,f32x16&p1,int jb,int qrel,int hi,lds_cfptr rtab){
  const float NEG=-INFINITY; int kb=64*jb+4*hi;
  lds_cfptr rp=rtab+(447-qrel+kb);
  #pragma unroll
  for(int r=0;r<16;++r){const int kvl=(r&3)+8*(r>>2); p0[r]+=rp[kvl]; p1[r]+=rp[kvl+32];}
  if(jb>=0){
  #pragma unroll
  for(int r=0;r<16;++r){int kv=kb+(r&3)+8*(r>>2); if(kv>qrel)p0[r]=NEG; if(kv+32>qrel)p1[r]=NEG;}
  }
}

constexpr int NSLOT=3, SLOTB=8192;
constexpr int LDS_K=0, LDS_V=NSLOT*SLOTB, LDS_WS=2*NSLOT*SLOTB, LDS_OST=LDS_WS+NW*64*4, LDS_BYTES=LDS_OST+NW*4096;
constexpr float C2=0.125f*1.4426950408889634f;
__device__ __forceinline__ void glds16(const void*gsrc,unsigned lds_dst){unsigned keep;
  asm volatile("s_mov_b32 %0, m0\n\ts_mov_b32 m0, %2\n\ts_nop 0\n\tglobal_load_lds_dwordx4 %1, off\n\ts_mov_b32 m0, %0":"=&s"(keep):"v"(gsrc),"s"(lds_dst):"memory");}
__device__ __forceinline__ float max3f(float a,float b,float c){float r;asm("v_max3_f32 %0, %1, %2, %3":"=v"(r):"v"(a),"v"(b),"v"(c));return r;}
__device__ __forceinline__ float max2f(float a,float b){float r;asm("v_max_f32_e32 %0, %1, %2":"=v"(r):"v"(a),"v"(b));return r;}
__device__ __forceinline__ float fadd_s(float a,float b){float r;asm("v_add_f32_e32 %0, %1, %2":"=v"(r):"v"(a),"v"(b));return r;}
__device__ __forceinline__ float fsub_s(float a,float b){float r;asm("v_sub_f32_e32 %0, %1, %2":"=v"(r):"v"(a),"v"(b));return r;}
typedef float f32x2_t __attribute__((ext_vector_type(2))); typedef __bf16 bf16x2_t __attribute__((ext_vector_type(2)));
__device__ __forceinline__ unsigned cvtpk_s(float lo,float hi){f32x2_t v={lo,hi};bf16x2_t b=__builtin_convertvector(v,bf16x2_t);return __builtin_bit_cast(unsigned,b);}
#define WAIT_BAR(N) asm volatile("s_waitcnt vmcnt(" #N ") lgkmcnt(0)\n\ts_barrier":::"memory")

__device__ __forceinline__ void qkt(f32x16&p0,f32x16&p1,const char*Kslot,const bf16x8*qr,int r32,int hi){
  const char*kb=Kslot+hi*1024+r32*16;
  #pragma unroll
  for(int d0=0;d0<4;++d0){
    const bf16x8 b0=*reinterpret_cast<const bf16x8*>(kb+d0*2048);
    const bf16x8 b1=*reinterpret_cast<const bf16x8*>(kb+d0*2048+512);
    if(d0==0){p0=__builtin_amdgcn_mfma_f32_32x32x16_bf16(b0,qr[0],f32x16{},0,0,0);p1=__builtin_amdgcn_mfma_f32_32x32x16_bf16(b1,qr[0],f32x16{},0,0,0);}
    else{p0=__builtin_amdgcn_mfma_f32_32x32x16_bf16(b0,qr[d0],p0,0,0,0);p1=__builtin_amdgcn_mfma_f32_32x32x16_bf16(b1,qr[d0],p1,0,0,0);}}
}
typedef __attribute__((address_space(3))) const char* lds_cptr;
typedef short v4i16_t __attribute__((ext_vector_type(4)));
__device__ __forceinline__ void kload8(bf16x8*kf,lds_cptr kp){
  kf[0]=*(const __attribute__((address_space(3))) bf16x8*)(kp);      kf[1]=*(const __attribute__((address_space(3))) bf16x8*)(kp+512);
  kf[2]=*(const __attribute__((address_space(3))) bf16x8*)(kp+2048); kf[3]=*(const __attribute__((address_space(3))) bf16x8*)(kp+2560);
  kf[4]=*(const __attribute__((address_space(3))) bf16x8*)(kp+4096); kf[5]=*(const __attribute__((address_space(3))) bf16x8*)(kp+4608);
  kf[6]=*(const __attribute__((address_space(3))) bf16x8*)(kp+6144); kf[7]=*(const __attribute__((address_space(3))) bf16x8*)(kp+6656);
}
__device__ __forceinline__ void kload2(bf16x8*kf,lds_cptr kp,int j){ kf[2*j]=*(const __attribute__((address_space(3))) bf16x8*)(kp+j*2048); kf[2*j+1]=*(const __attribute__((address_space(3))) bf16x8*)(kp+j*2048+512); }
__device__ __forceinline__ s16x4 vtr(lds_cptr p){ return __builtin_bit_cast(s16x4,__builtin_amdgcn_ds_read_tr16_b64_v4i16((__attribute__((address_space(3))) v4i16_t*)p)); }
__device__ __forceinline__ float rowmax(const f32x16&p0,const f32x16&p1){
  float a=max3f(p0[0],p0[1],p1[0]),b=max3f(p0[2],p0[3],p1[1]);a=max3f(a,p1[2],p1[3]);
  #pragma unroll
  for(int r=4;r<16;r+=4){a=max3f(a,p0[r],p0[r+1]);b=max3f(b,p0[r+2],p0[r+3]);a=max3f(a,p1[r],p1[r+1]);b=max3f(b,p1[r+2],p1[r+3]);}
  const float m=max2f(a,b);
  auto rr=__builtin_amdgcn_permlane32_swap(__float_as_uint(m),__float_as_uint(m),false,false);
  return max2f(__uint_as_float(rr[0]),__uint_as_float(rr[1]));
}
__device__ __forceinline__ void pv(f32x16*o,int vb,bf16x8 pa0,bf16x8 pa1,bf16x8 pa2,bf16x8 pa3){
  #pragma unroll
  for(int d0=0;d0<2;++d0){s16x4 lo[4],hi[4];
    #pragma unroll
    for(int ks=0;ks<4;++ks){
      asm volatile("ds_read_b64_tr_b16 %0,%1 offset:%c2":"=&v"(lo[ks]):"v"(vb),"i"(d0*4096+ks*1024):"memory");
      asm volatile("ds_read_b64_tr_b16 %0,%1 offset:%c2":"=&v"(hi[ks]):"v"(vb),"i"(d0*4096+ks*1024+512):"memory");}
    asm volatile("s_waitcnt lgkmcnt(0)":::"memory");SBAR();
    #define PK(k) (bf16x8){lo[k][0],lo[k][1],lo[k][2],lo[k][3],hi[k][0],hi[k][1],hi[k][2],hi[k][3]}
    o[d0]=__builtin_amdgcn_mfma_f32_32x32x16_bf16(pa0,PK(0),o[d0],0,0,0);
    o[d0]=__builtin_amdgcn_mfma_f32_32x32x16_bf16(pa1,PK(1),o[d0],0,0,0);
    o[d0]=__builtin_amdgcn_mfma_f32_32x32x16_bf16(pa2,PK(2),o[d0],0,0,0);
    o[d0]=__builtin_amdgcn_mfma_f32_32x32x16_bf16(pa3,PK(3),o[d0],0,0,0);
    #undef PK
  }
}

#ifndef ATTN_STORE16
#define ATTN_STORE16(p,v) (*(u32x4*)(p)=(v))
#endif
template<int THRL> __device__ __forceinline__ void attn_unit(long rowbase,int qcol,int kcol,int vcol,int ocol,int qb,const bf16*__restrict__ Z,bf16*O,char*shm,lds_cfptr rtab){
  int tid_=threadIdx.x; asm volatile("":"+v"(tid_));
  const int tid=tid_,lane=tid&63,r32=lane&31,hi=lane>>5; const int wid=__builtin_amdgcn_readfirstlane(tid>>6);
  const int q0=qb*QB;
  const bf16*Qw=Z+(rowbase+q0+wid*QBLK)*ZP+qcol;
  const bf16*Kh=Z+rowbase*ZP+kcol,*Vh=Z+rowbase*ZP+vcol;
  const unsigned lds0=(unsigned)(uintptr_t)shm;
  float*wsf=(float*)(shm+LDS_WS)+wid*64;
  const bf16*ksrc=Kh+(long)lane*ZP+wid*8;
  const bf16*vsrc=Vh+(long)(16*(wid&3)+(lane>>2))*ZP+(wid>>2)*32+(lane&3)*8;
  const unsigned kdst=lds0+LDS_K+wid*1024, vdst=lds0+LDS_V+wid*1024;
  #define DMA_K(t,slot) glds16(ksrc+(long)(t)*KVBLK*ZP,(unsigned)__builtin_amdgcn_readfirstlane(kdst+(slot)))
  #define DMA_V(t,slot) glds16(vsrc+(long)(t)*KVBLK*ZP,(unsigned)__builtin_amdgcn_readfirstlane(vdst+(slot)))
  const int vb0=(int)(lds0+LDS_V)+((lane>>4)&1)*32+(lane&3)*8+(4*hi+((lane&15)>>2))*64;
  const char*Kbase=shm+LDS_K; bf16x8 kf[8];
  const lds_cptr shm3=(lds_cptr)shm; const lds_cptr kp0=shm3+LDS_K+hi*1024+r32*16; const lds_cptr vp0=shm3+LDS_V+((lane>>4)&1)*32+(lane&3)*8+(4*hi+((lane&15)>>2))*64;
  const int NT=(q0+QB)/KVBLK;
  DMA_K(0,0);DMA_V(0,0);DMA_K(1,SLOTB);
  bf16x8 qr[4];
  #pragma unroll
  for(int d0=0;d0<4;++d0)qr[d0]=*reinterpret_cast<const bf16x8*>(&Qw[(long)r32*ZP+d0*16+hi*8]);
  float mhat=0.f,l_reg=0.f;f32x16 o[2];o[0]=f32x16{};o[1]=f32x16{};
  const int qrel=wid*QBLK+r32;
  #define CMASK(P0,P1,t) do{int jb_=(t)-(NT-4); if(jb_>=-3)cmask(P0,P1,jb_,qrel,hi,rtab);}while(0)
  bool resc=false;
  #define START(P0,P1) do{ const float rm=rowmax(P0,P1); resc=false; mhat=rm; \
    _Pragma("unroll") for(int r=0;r<16;++r)P0[r]=__builtin_amdgcn_exp2f(fsub_s(P0[r],mhat)); }while(0)
  #define RESC() do{ if(resc){ asm volatile("s_waitcnt lgkmcnt(0)":::"memory"); \
      _Pragma("unroll") for(int d_=0;d_<2;++d_) _Pragma("unroll") for(int r=0;r<16;++r)o[d_][r]*=wsf[crow(r,hi)]; } }while(0)
  f32x16 pA0,pA1,pB0,pB1;
  int sl_prev=0,sl_cur=0,sl_next=SLOTB;
  #define ROT() do{sl_prev=sl_cur;sl_cur=sl_next;sl_next=(sl_next==(NSLOT-1)*SLOTB)?0:sl_next+SLOTB;}while(0)
  DMA_K(2,2*SLOTB);
  WAIT_BAR(3);
  qkt(pA0,pA1,Kbase,qr,r32,hi);asm volatile("s_nop 15\n\ts_nop 7":"+v"(pA0),"+v"(pA1));CMASK(pA0,pA1,0);
  START(pA0,pA1);
  _Pragma("unroll") for(int r=0;r<16;++r)pA1[r]=__builtin_amdgcn_exp2f(pA1[r]-mhat);
  WAIT_BAR(0);
  DMA_K(3,0);DMA_V(1,SLOTB);
  ROT();
  kload8(kf,kp0+sl_cur);
  WAIT_BAR(2);
  s16x4 vlo[8],vhi[8]; u32x4 pw0,pw1,pw2,pw3;
  #define PKW(P,B) cvtpk_s(P[B],P[B+1])
  #define PAF(k) __builtin_bit_cast(bf16x8,pw##k)
  #define VFR(i) (bf16x8){vlo[i][0],vlo[i][1],vlo[i][2],vlo[i][3],vhi[i][0],vhi[i][1],vhi[i][2],vhi[i][3]}
  #define PIN(x) asm volatile("":"+v"(x))
  #define MX3(a,b,c) __builtin_fmaxf(__builtin_fmaxf((a),(b)),(c))
  #define GAPA(MF,A0,A1,A2,A3,W0,W1,PW) do{ MF; sacc+=A0; sacc+=A1; sacc+=A2; sacc+=A3; PIN(sacc); W0; W1; PIN(PW); SBAR(); }while(0)
  #define EX(v) __builtin_amdgcn_exp2f(v)
  #define GAPB(MF,X,B) do{ MF; X[B]=EX(X[B]-mhat); X[B+1]=EX(X[B+1]-mhat); X[B+2]=EX(X[B+2]-mhat); X[B+3]=EX(X[B+3]-mhat); PIN(X); SBAR(); }while(0)
  #define VRD(i) do{ vlo[i]=vtr(vp_+(((i)>>2)*4096+((i)&3)*1024)); vhi[i]=vtr(vp_+(((i)>>2)*4096+((i)&3)*1024+512)); }while(0)
  #define KRD(G,j) do{ if(G){ kload2(kf,kp0+sl_next,j); SBAR(); } }while(0)
  #define STEP(C0,C1,P0,P1,t,GK,GV,GL) do{ SBAR(); \
    const lds_cptr vp_=vp0+sl_prev; \
    VRD(0); SBAR(); float sacc=(P0[0]+P0[1]); \
    GAPA(C0=__builtin_amdgcn_mfma_f32_32x32x16_bf16(kf[0],qr[0],f32x16{},0,0,0), P0[2],P0[3],P0[4],P0[5],     pw0[0]=PKW(P0,0), pw0[1]=PKW(P0,2), pw0); \
    VRD(4); SBAR(); GAPA(C1=__builtin_amdgcn_mfma_f32_32x32x16_bf16(kf[1],qr[0],f32x16{},0,0,0), P0[6],P0[7],P0[8],P0[9],     pw0[2]=PKW(P0,4), pw0[3]=PKW(P0,6), pw0); \
    VRD(1); SBAR(); GAPA(C0=__builtin_amdgcn_mfma_f32_32x32x16_bf16(kf[2],qr[1],C0,0,0,0),   P0[10],P0[11],P0[12],P0[13], pw1[0]=PKW(P0,8), pw1[1]=PKW(P0,10), pw1); \
    VRD(5); SBAR(); GAPA(C1=__builtin_amdgcn_mfma_f32_32x32x16_bf16(kf[3],qr[1],C1,0,0,0),   P0[14],P0[15],P1[0],P1[1],   pw1[2]=PKW(P0,12),pw1[3]=PKW(P0,14), pw1); \
    VRD(2); SBAR(); GAPA(C0=__builtin_amdgcn_mfma_f32_32x32x16_bf16(kf[4],qr[2],C0,0,0,0),   P1[2],P1[3],P1[4],P1[5],     pw2[0]=PKW(P1,0), pw2[1]=PKW(P1,2), pw2); \
    VRD(6); SBAR(); GAPA(C1=__builtin_amdgcn_mfma_f32_32x32x16_bf16(kf[5],qr[2],C1,0,0,0),   P1[6],P1[7],P1[8],P1[9],     pw2[2]=PKW(P1,4), pw2[3]=PKW(P1,6), pw2); \
    VRD(3); SBAR(); GAPA(C0=__builtin_amdgcn_mfma_f32_32x32x16_bf16(kf[6],qr[3],C0,0,0,0),   P1[10],P1[11],P1[12],P1[13], pw3[0]=PKW(P1,8), pw3[1]=PKW(P1,10), pw3); \
    VRD(7); SBAR(); GAPA(C1=__builtin_amdgcn_mfma_f32_32x32x16_bf16(kf[7],qr[3],C1,0,0,0),   P1[14],P1[15],0.f,0.f,       pw3[2]=PKW(P1,12),pw3[3]=PKW(P1,14), pw3); \
    l_reg+=sacc; \
    if(GK){DMA_K((t)+3,sl_cur);} if(GV){DMA_V((t)+1,sl_next);} \
    CMASK(C0,C1,t); \
    { float a=MX3(C0[0],C0[1],C1[0]),b=MX3(C0[2],C0[3],C1[1]); a=MX3(a,C1[2],C1[3]); \
      _Pragma("unroll") for(int r=4;r<16;r+=4){a=MX3(a,C0[r],C0[r+1]);b=MX3(b,C0[r+2],C0[r+3]);a=MX3(a,C1[r],C1[r+1]);b=MX3(b,C1[r+2],C1[r+3]);} \
      float rm=__builtin_fmaxf(a,b); { auto rr=__builtin_amdgcn_permlane32_swap(__float_as_uint(rm),__float_as_uint(rm),false,false); rm=__builtin_fmaxf(__uint_as_float(rr[0]),__uint_as_float(rr[1])); } \
      resc=false; rm-=mhat; \
      if(__builtin_expect(__any(rm>(float)THRL),0)){ const float dl=__builtin_fmaxf(rm,0.f); mhat+=dl; \
        const float f=__builtin_amdgcn_exp2f(-dl); l_reg*=f; if(hi==0)wsf[r32]=f; resc=true; } } \
    SBAR(); \
    GAPB(o[0]=__builtin_amdgcn_mfma_f32_32x32x16_bf16(PAF(0),VFR(0),o[0],0,0,0), C0,0); \
    GAPB(o[1]=__builtin_amdgcn_mfma_f32_32x32x16_bf16(PAF(0),VFR(4),o[1],0,0,0), C0,4); \
    KRD(GL,0); GAPB(o[0]=__builtin_amdgcn_mfma_f32_32x32x16_bf16(PAF(1),VFR(1),o[0],0,0,0), C0,8); \
    KRD(GL,1); GAPB(o[1]=__builtin_amdgcn_mfma_f32_32x32x16_bf16(PAF(1),VFR(5),o[1],0,0,0), C0,12); \
    KRD(GL,2); GAPB(o[0]=__builtin_amdgcn_mfma_f32_32x32x16_bf16(PAF(2),VFR(2),o[0],0,0,0), C1,0); \
    KRD(GL,3); GAPB(o[1]=__builtin_amdgcn_mfma_f32_32x32x16_bf16(PAF(2),VFR(6),o[1],0,0,0), C1,4); \
    GAPB(o[0]=__builtin_amdgcn_mfma_f32_32x32x16_bf16(PAF(3),VFR(3),o[0],0,0,0), C1,8); \
    GAPB(o[1]=__builtin_amdgcn_mfma_f32_32x32x16_bf16(PAF(3),VFR(7),o[1],0,0,0), C1,12); \
    }while(0)
  int t=1;
  #undef CMASK
  #define CMASK(P0,P1,t) do{}while(0)
  for(;t+7<NT;t+=2){
    STEP(pB0,pB1,pA0,pA1,t,true,true,true);     WAIT_BAR(2); RESC(); ROT();
    STEP(pA0,pA1,pB0,pB1,t+1,true,true,true);   WAIT_BAR(2); RESC(); ROT();
  }
  #undef CMASK
  #define CMASK(P0,P1,t) do{int jb_=(t)-(NT-4); if(jb_>=-3)cmask(P0,P1,jb_,qrel,hi,rtab);}while(0)
  #define ENDW(tt) do{ if((tt)+3<NT){WAIT_BAR(2);} else if((tt)+2<NT){WAIT_BAR(1);} else {WAIT_BAR(0);} }while(0)
  for(;t+1<NT;t+=2){
    STEP(pB0,pB1,pA0,pA1,t,(t+3<NT),(t+1<NT),(t+1<NT));       ENDW(t);   RESC(); ROT();
    STEP(pA0,pA1,pB0,pB1,t+1,(t+4<NT),(t+2<NT),(t+2<NT));     ENDW(t+1); RESC(); ROT();
  }
  STEP(pB0,pB1,pA0,pA1,NT-1,false,false,false); RESC();
  { float sacc=pB0[0]+pB0[1]; _Pragma("unroll") for(int r=2;r<16;++r)sacc+=pB0[r]; _Pragma("unroll") for(int r=0;r<16;++r)sacc+=pB1[r]; l_reg+=sacc;
    pw0=(u32x4){PKW(pB0,0),PKW(pB0,2),PKW(pB0,4),PKW(pB0,6)};pw1=(u32x4){PKW(pB0,8),PKW(pB0,10),PKW(pB0,12),PKW(pB0,14)};pw2=(u32x4){PKW(pB1,0),PKW(pB1,2),PKW(pB1,4),PKW(pB1,6)};pw3=(u32x4){PKW(pB1,8),PKW(pB1,10),PKW(pB1,12),PKW(pB1,14)};
    SBAR(); pv(o,vb0+sl_cur,PAF(0),PAF(1),PAF(2),PAF(3)); }
  #undef PKW
  #undef PAF
  #undef VFR
  #undef PIN
  #undef MX3
  #undef GAPA
  #undef GAPB
  #undef EX
  #undef VRD
  #undef KRD
  #undef STEP
  #undef ENDW
  {auto rr=__builtin_amdgcn_permlane32_swap(__float_as_uint(l_reg),__float_as_uint(l_reg),false,false);l_reg=__uint_as_float(rr[0])+__uint_as_float(rr[1]);}
  if(hi==0)wsf[32+r32]=l_reg;asm volatile("s_waitcnt lgkmcnt(0)":::"memory");
  float rli[16];
  #pragma unroll
  for(int r=0;r<16;++r)rli[r]=__builtin_amdgcn_rcpf(wsf[32+crow(r,hi)]);
  bf16*Ow=O+(rowbase+q0+wid*QBLK)*OP+ocol;
  { bf16*stg=(bf16*)(shm+LDS_OST)+wid*2048;
    #pragma unroll
    for(int r=0;r<16;++r){const int orow=crow(r,hi);
      #pragma unroll
      for(int d0=0;d0<2;++d0)stg[orow*64+d0*32+r32]=__float2bfloat16(o[d0][r]*rli[r]);}
    asm volatile("s_waitcnt lgkmcnt(0)":::"memory");
    #pragma unroll
    for(int i=0;i<4;++i){const int row=i*8+(lane>>3),ch=lane&7; const u32x4 v=*(const u32x4*)(stg+row*64+ch*8); ATTN_STORE16(Ow+(long)row*OP+ch*8,v);} }
  asm volatile("s_waitcnt lgkmcnt(0)\n\ts_barrier":::"memory");
  #undef DMA_K
  #undef DMA_V
  #undef CMASK
  #undef START
  #undef RESC
  #undef ROT
}
constexpr int ATTN_LDS_BYTES=LDS_BYTES;
#undef SBAR
#undef WAIT_BAR
}
#define GAS __attribute__((address_space(1)))
#define LAS __attribute__((address_space(3)))
typedef unsigned short bf16;
typedef unsigned v4u __attribute__((ext_vector_type(4)));
typedef float f32x4 __attribute__((ext_vector_type(4)));
typedef short bf16x8 __attribute__((ext_vector_type(8)));
typedef GAS unsigned gu32;
typedef GAS unsigned long long gu64;
#define RLX_AGENT __ATOMIC_RELAXED, __HIP_MEMORY_SCOPE_AGENT
#define LDS_WAIT() asm volatile("s_waitcnt lgkmcnt(0)" ::: "memory")
#define VM_WAIT() asm volatile("s_waitcnt vmcnt(0)" ::: "memory")
__device__ __forceinline__ unsigned long long rt() { return __builtin_amdgcn_s_memrealtime(); }
__device__ __forceinline__ unsigned f2bf(float f) { unsigned u = __builtin_bit_cast(unsigned, f); return (u + 0x7fffu + ((u >> 16) & 1u)) >> 16; }
__device__ __forceinline__ unsigned pk2(float lo, float hi) { return f2bf(lo) | (f2bf(hi) << 16); }
#define XB_TMO      128
#define XB_XCNT(j)  (256  + 64 * (j))
#define XB_XSUB(j)  (1280 + 64 * (j))
#define XB_XGEN(j)  (2304 + 64 * (j))
#define XB_TOP      3328
#define XB_TOPGEN   3392
#define XCD_BAR_WORDS 3456
#define XB_SPIN_CAP (1u << 18)

__device__ __forceinline__ unsigned xb_ld(unsigned* p)              { return __hip_atomic_load(p, __ATOMIC_RELAXED, __HIP_MEMORY_SCOPE_AGENT); }
__device__ __forceinline__ unsigned xb_add(unsigned* p, unsigned v) { return __hip_atomic_fetch_add(p, v, __ATOMIC_RELAXED, __HIP_MEMORY_SCOPE_AGENT); }
__device__ __forceinline__ unsigned xb_xcc_id() { return (unsigned)__builtin_amdgcn_s_getreg((3 << 11) | 20) & 0xFu; }
#define XB_SPIN(cond, bar) do { unsigned _sp = 0; while (cond) { __builtin_amdgcn_s_sleep(1); \
    if ((++_sp & 255u) == 0u) { if (xb_ld(&(bar)[XB_TMO])) break; if (_sp > XB_SPIN_CAP) { atomicAdd(&(bar)[XB_TMO], 1u); break; } } } } while (0)

struct XcdBarrier {
    unsigned* bar; unsigned x;
    volatile LAS unsigned* st;
};

__device__ __forceinline__ XcdBarrier xcd_barrier_post(unsigned* bar, volatile LAS unsigned* st) {
    XcdBarrier b; b.bar = bar; b.x = xb_xcc_id(); b.st = st;
    if (threadIdx.x == 0) (void)xb_add(&bar[XB_XCNT(b.x)], 1u);
    return b;
}
__device__ __forceinline__ void xcd_barrier_complete(unsigned* bar, unsigned x, unsigned& nloc, unsigned& nx) {
    const unsigned G = gridDim.x * gridDim.y * gridDim.z;
    unsigned sum, cnt, mine, sp = 0u;
    for (;;) {
        sum = 0u; cnt = 0u; mine = 0u;
#pragma unroll
        for (unsigned j = 0; j < 16; ++j) { const unsigned c = xb_ld(&bar[XB_XCNT(j)]); sum += c; cnt += (c > 0u) ? 1u : 0u; mine = (j == x) ? c : mine; }
        if (sum == G) break;
        __builtin_amdgcn_s_sleep(1);
        if ((++sp & 255u) == 0u) { if (xb_ld(&bar[XB_TMO])) break; if (sp > XB_SPIN_CAP) { atomicAdd(&bar[XB_TMO], 1u); break; } }
    }
    nloc = mine > 0u ? mine : 1u; nx = cnt > 0u ? cnt : 1u;
}

__device__ __forceinline__ void xcd_barrier(const XcdBarrier& b) {
    asm volatile("s_waitcnt vmcnt(0)" ::: "memory");
    __syncthreads();
    if (threadIdx.x == 0) {
        unsigned* bar = b.bar;
        __builtin_amdgcn_s_waitcnt(0);
        unsigned nloc = b.st[0], nx = b.st[1];
        if (nloc == 0u) { xcd_barrier_complete(bar, b.x, nloc, nx); b.st[0] = nloc; b.st[1] = nx; }
        const unsigned old = xb_add(&bar[XB_XSUB(b.x)], 1u);
        const unsigned gen = old / nloc;
        if (old + 1u == (gen + 1u) * nloc) {
            __builtin_amdgcn_fence(__ATOMIC_RELEASE, "agent");
            asm volatile("s_waitcnt vmcnt(0)" ::: "memory");
            const unsigned og = xb_add(&bar[XB_TOP], 1u);
            const unsigned tg = og / nx;
            if (og + 1u == (tg + 1u) * nx) xb_add(&bar[XB_TOPGEN], 1u);
            else XB_SPIN(xb_ld(&bar[XB_TOPGEN]) == tg, bar);
            __builtin_amdgcn_fence(__ATOMIC_ACQUIRE, "agent");
            xb_add(&bar[XB_XGEN(b.x)], 1u);
            asm volatile("s_waitcnt vmcnt(0)" ::: "memory");
        } else {
            XB_SPIN(xb_ld(&bar[XB_XGEN(b.x)]) == gen, bar);
            __builtin_amdgcn_fence(__ATOMIC_ACQUIRE, "agent");
            asm volatile("s_waitcnt vmcnt(0)" ::: "memory");
        }
    }
    __syncthreads();
}

typedef unsigned v2u __attribute__((ext_vector_type(2)));
typedef float f32x2 __attribute__((ext_vector_type(2)));
typedef __bf16 bf16x2v __attribute__((ext_vector_type(2)));
__device__ __forceinline__ unsigned pkbf(float lo, float hi) { f32x2 v = {lo, hi}; bf16x2v b = __builtin_convertvector(v, bf16x2v); return __builtin_bit_cast(unsigned, b); }
__device__ __forceinline__ float bflo(unsigned w) { return __builtin_bit_cast(float, w << 16); }
__device__ __forceinline__ float bfhi(unsigned w) { return __builtin_bit_cast(float, w & 0xffff0000u); }
__device__ __forceinline__ float wave_sum(float v) {
#pragma unroll
    for (int o = 1; o < 64; o <<= 1) v += __shfl_xor(v, o);
    return v;
}
__device__ __forceinline__ bf16x8 pack8(f32x4 a, f32x4 b) { v4u w; w.x = pkbf(a[0], a[1]); w.y = pkbf(a[2], a[3]); w.z = pkbf(b[0], b[1]); w.w = pkbf(b[2], b[3]); return __builtin_bit_cast(bf16x8, w); }
#define MFMA16(a, b, c) __builtin_amdgcn_mfma_f32_16x16x32_bf16((a), (b), (c), 0, 0, 0)

struct Args { const float* in[29]; float* out; unsigned char* ws; int ph_lo, ph_hi; };
static_assert(sizeof(Args) == 256, "Args has no padding");
enum { I_XP = 0, I_XS, I_CP, I_CS, I_CK, I_CV, I_PT, I_SP, I_SC, I_WADA, I_BADA, I_GPM, I_GQM, I_GPF, I_GQF, I_WIN, I_WOUT, I_WPOOL, I_PSCALE,
       I_LQ1, I_LK1, I_LQ2, I_LK2, I_GHEAD, I_RELB, I_WUP, I_CONVW, I_CONVB, I_WDN };

struct EpiZ {
    static constexpr bool PERM = true, AFTER_DRAIN = false;
    bf16* Z; float* out;
    __device__ __forceinline__ void operator()(const pg8::f32x4 (&acc)[2][2][4][2], const pg8::Unit& u, int wr, int wc, int fr, int fq) const {
        const int region = u.pn >> 1;
        const float sc = region == 1 ? QSCALE : 1.f;
        const int rowt = u.pm * 256 + wr * 64 + fr, colt = u.pn * 256 + wc * 32 + 8 * fq, colr = colt - region * 512;
#pragma unroll
        for (int ai = 0; ai < 2; ++ai)
#pragma unroll
            for (int m = 0; m < 4; ++m) {
                const int row = rowt + ai * 128 + m * 16;
                bf16* zp = Z + (size_t)row * PROJ + colt;
#pragma unroll
                for (int bj = 0; bj < 2; ++bj) { const pg8::f32x4 v0 = acc[ai][bj][m][0] * sc, v1 = acc[ai][bj][m][1] * sc;
                    v4u w; w.x = pkbf(v0[0], v0[1]); w.y = pkbf(v0[2], v0[3]); w.z = pkbf(v1[0], v1[1]); w.w = pkbf(v1[2], v1[3]); *(v4u*)(zp + bj * 128) = w; }
                float* op = nullptr;
                if (region >= 2) {
                    op = (row < MP) ? out + (region == 2 ? O_KP : O_VP) + (size_t)row * 512 : out + (region == 2 ? O_KS : O_VS) + (size_t)(row - MP) * 512;
                } else if (region == 0) {
                    if (row < MP) { const int t = row & (TP - 1); if (t >= TP - 15) op = out + O_PP + (size_t)((row >> 11) * 15 + (t - (TP - 15))) * 512; }
                    else { const int r = row - MP; op = out + O_PS + (size_t)((r >> 3) * 15 + 7 + (r & 7)) * 512; }
                }
                if (op) {
#pragma unroll
                    for (int bj = 0; bj < 2; ++bj) { *(pg8::f32x4*)(op + colr + bj * 128) = acc[ai][bj][m][0]; *(pg8::f32x4*)(op + colr + bj * 128 + 4) = acc[ai][bj][m][1]; }
                }
            }
    }
};
struct EpiPlain {
    static constexpr bool PERM = true, AFTER_DRAIN = false;
    bf16* O; int ldc;
    __device__ __forceinline__ void operator()(const pg8::f32x4 (&acc)[2][2][4][2], const pg8::Unit& u, int wr, int wc, int fr, int fq) const {
        const int rowt = u.pm * 256 + wr * 64 + fr, colt = u.pn * 256 + wc * 32 + 8 * fq;
#pragma unroll
        for (int ai = 0; ai < 2; ++ai)
#pragma unroll
            for (int m = 0; m < 4; ++m) {
                bf16* zp = O + (size_t)(rowt + ai * 128 + m * 16) * ldc + colt;
#pragma unroll
                for (int bj = 0; bj < 2; ++bj) { const pg8::f32x4 v0 = acc[ai][bj][m][0], v1 = acc[ai][bj][m][1];
                    v4u w; w.x = pkbf(v0[0], v0[1]); w.y = pkbf(v0[2], v0[3]); w.z = pkbf(v1[0], v1[1]); w.w = pkbf(v1[2], v1[3]); *(v4u*)(zp + bj * 128) = w; }
            }
    }
};
__device__ __forceinline__ float gelu_tanh(float x) { const float u = -2.3022081981748974f * (x + 0.044715f * x * x * x); return x * __builtin_amdgcn_rcpf(1.f + __builtin_amdgcn_exp2f(u)); }
__device__ __forceinline__ float dpp_ror1(float x) { return __builtin_bit_cast(float, __builtin_amdgcn_update_dpp(0, __builtin_bit_cast(int, x), 0x121, 0xf, 0xf, false)); }
__device__ __forceinline__ float dpp_ror2(float x) { return __builtin_bit_cast(float, __builtin_amdgcn_update_dpp(0, __builtin_bit_cast(int, x), 0x122, 0xf, 0xf, false)); }
struct EpiConvGlu {
    static constexpr bool PERM = true, AFTER_DRAIN = false;
    bf16* U; bf16* ACT; float* UH; float* out; const float* cw; const float* cb; LAS unsigned char* xl;
    __device__ __forceinline__ void operator()(const pg8::f32x4 (&acc)[2][2][4][2], const pg8::Unit& u, int wr, int wc, int fr, int fq) const {
        const int rowt = u.pm * 256 + wr * 64 + fr, jg0 = u.pn * 128 + wc * 32 + 8 * fq;
        if (u.pm >= MP / 256) {
            const int colt = u.pn * 256 + wc * 32 + 8 * fq;
#pragma unroll
            for (int ai = 0; ai < 2; ++ai)
#pragma unroll
                for (int m = 0; m < 4; ++m) {
                    const int row = rowt + ai * 128 + m * 16, r = row - MP;
                    bf16* zp = U + (size_t)row * UPW + colt;
#pragma unroll
                    for (int bj = 0; bj < 2; ++bj) { const pg8::f32x4 v0 = acc[ai][bj][m][0], v1 = acc[ai][bj][m][1];
                        v4u w; w.x = pkbf(v0[0], v0[1]); w.y = pkbf(v0[2], v0[3]); w.z = pkbf(v1[0], v1[1]); w.w = pkbf(v1[2], v1[3]); *(v4u*)(zp + bj * 128) = w; }
                    if ((r & 7) >= 6) { float* op = out + O_CS + (size_t)((r >> 3) * 2 + ((r & 7) - 6)) * UPW + jg0;
#pragma unroll
                        for (int bj = 0; bj < 2; ++bj) { *(pg8::f32x4*)(op + bj * FF) = acc[ai][bj][m][0]; *(pg8::f32x4*)(op + bj * FF + 4) = acc[ai][bj][m][1]; } }
                }
            return;
        }
        LAS pg8::f32x4* X = (LAS pg8::f32x4*)xl; LAS float* Pm = (LAS float*)(xl + 8192);
        if (fr >= 14) {
#pragma unroll
            for (int ai = 0; ai < 2; ++ai) { const int b = (((((ai * 2 + wr) * 4 + wc) * 4 + fq) * 2) + (fr - 14)) * 4;
                X[b] = acc[ai][0][3][0]; X[b + 1] = acc[ai][0][3][1]; X[b + 2] = acc[ai][1][3][0]; X[b + 3] = acc[ai][1][3][1]; }
        }
        { const int t = ((wr * 4 + wc) * 4 + fq) * 16 + fr;
#pragma unroll
          for (int i = 0; i < 2; ++i) { const int idx = t + 512 * i, p = idx >> 8, c = idx & 255, col = (c < 128 ? 0 : FF - 128) + u.pn * 128 + c; Pm[idx] = p < 3 ? cw[p * UPW + col] : cb[col]; } }
        asm volatile("s_waitcnt vmcnt(0) lgkmcnt(0)" ::: "memory"); __builtin_amdgcn_s_barrier(); asm volatile("" ::: "memory");
        const bool l15 = fr == 15, l14 = fr >= 14;
        const int pc = wc * 32 + 8 * fq;
#pragma unroll
        for (int ai = 0; ai < 2; ++ai) {
            pg8::f32x4 pv[4];
            const int o = ai * 2 + wr;
            if (o == 0) { pv[0] = (pg8::f32x4){0.f, 0.f, 0.f, 0.f}; pv[1] = pv[0]; pv[2] = pv[0]; pv[3] = pv[0]; }
            else { const int b = ((((((o - 1) * 4 + wc) * 4 + fq) * 2) + (l14 ? fr - 14 : 0))) * 4; pv[0] = X[b]; pv[1] = X[b + 1]; pv[2] = X[b + 2]; pv[3] = X[b + 3]; }
#pragma unroll
            for (int m = 0; m < 4; ++m) {
                const pg8::f32x4 cur[4] = {acc[ai][0][m][0], acc[ai][0][m][1], acc[ai][1][m][0], acc[ai][1][m][1]};
                unsigned pk[4];
#pragma unroll
                for (int n = 0; n < 2; ++n) {
                    asm volatile("" ::: "memory");
                    const pg8::f32x4 w0g = *(const LAS pg8::f32x4*)(Pm + pc + 4 * n), w1g = *(const LAS pg8::f32x4*)(Pm + 256 + pc + 4 * n), w2g = *(const LAS pg8::f32x4*)(Pm + 512 + pc + 4 * n), bg = *(const LAS pg8::f32x4*)(Pm + 768 + pc + 4 * n);
                    const pg8::f32x4 w0v = *(const LAS pg8::f32x4*)(Pm + 128 + pc + 4 * n), w1v = *(const LAS pg8::f32x4*)(Pm + 384 + pc + 4 * n), w2v = *(const LAS pg8::f32x4*)(Pm + 640 + pc + 4 * n), bv = *(const LAS pg8::f32x4*)(Pm + 896 + pc + 4 * n);
                    float r[4];
#pragma unroll
                    for (int k = 0; k < 4; ++k) { const float gv = cur[n][k], vv_ = cur[2 + n][k];
                        const float g1 = dpp_ror1(l15 ? pv[n][k] : gv), g2 = dpp_ror2(l14 ? pv[n][k] : gv);
                        const float v1 = dpp_ror1(l15 ? pv[2 + n][k] : vv_), v2 = dpp_ror2(l14 ? pv[2 + n][k] : vv_);
                        const float gc = bg[k] + w0g[k] * g2 + w1g[k] * g1 + w2g[k] * gv, vc = bv[k] + w0v[k] * v2 + w1v[k] * v1 + w2v[k] * vv_;
                        r[k] = gelu_tanh(gc) * vc; }
                    pk[2 * n] = pkbf(r[0], r[1]); pk[2 * n + 1] = pkbf(r[2], r[3]);
                }
                const int row = rowt + ai * 128 + m * 16;
                { v4u w; w.x = pk[0]; w.y = pk[1]; w.z = pk[2]; w.w = pk[3]; *(v4u*)(ACT + (size_t)row * FF + jg0) = w; }
                if (o == 0 && m == 0 && fr < 2) { float* hp = UH + (size_t)(u.pm * 4 + fr) * UPW + jg0;
                    *(pg8::f32x4*)hp = cur[0]; *(pg8::f32x4*)(hp + 4) = cur[1]; *(pg8::f32x4*)(hp + FF) = cur[2]; *(pg8::f32x4*)(hp + FF + 4) = cur[3]; }
                if (o == 3 && m == 3 && l14) { float* hp = UH + (size_t)(u.pm * 4 + 2 + (fr - 14)) * UPW + jg0;
                    *(pg8::f32x4*)hp = cur[0]; *(pg8::f32x4*)(hp + 4) = cur[1]; *(pg8::f32x4*)(hp + FF) = cur[2]; *(pg8::f32x4*)(hp + FF + 4) = cur[3];
                    if ((u.pm & 7) == 7) { float* op = out + O_CP + (size_t)((u.pm >> 3) * 2 + (fr - 14)) * UPW + jg0;
                        *(pg8::f32x4*)op = cur[0]; *(pg8::f32x4*)(op + 4) = cur[1]; *(pg8::f32x4*)(op + FF) = cur[2]; *(pg8::f32x4*)(op + FF + 4) = cur[3]; } }
#pragma unroll
                for (int q = 0; q < 4; ++q) pv[q] = cur[q];
            }
        }
    }
};
constexpr int ST_STR = 272, ST_BUF = 64 * ST_STR;
template <class Epi, int MR = 1> __device__ __forceinline__ void gemm_small_tile(LAS unsigned char* lds, const bf16* A, const bf16* Bt, int K, int row0, int col0, int tid, const Epi& E) {
    const int wave = __builtin_amdgcn_readfirstlane(tid >> 6), lane = tid & 63, m = lane & 15, kg = lane >> 4, mb = wave & 3, nh = wave >> 2;
    constexpr int BUFB = (MR + 1) * ST_BUF, BOFF = MR * ST_BUF;
    const int pr0 = tid >> 4, pc = tid & 15;
    const bf16* ga = A + (size_t)(row0 + pr0) * K + pc * 8; const bf16* gb = Bt + (size_t)(col0 + pr0) * K + pc * 8;
    const int so = pr0 * ST_STR + pc * 16;
    const int ra = (mb * MR * 16 + m) * ST_STR + kg * 16, rb0 = BOFF + (nh * 32 + m) * ST_STR + kg * 16, rb1 = rb0 + 16 * ST_STR;
    pg8::f32x4 acc[MR][2];
#pragma unroll
    for (int j = 0; j < MR; ++j) { acc[j][0] = (pg8::f32x4){0.f, 0.f, 0.f, 0.f}; acc[j][1] = acc[j][0]; }
    constexpr int NSET = (MR == 1) ? 4 : 2;
    v4u Ra[NSET][2 * MR], Rb[NSET][2];
#define ST_LOAD(c_, r_) do { const int ko_ = (c_) * 128; _Pragma("unroll") for (int i_ = 0; i_ < 2 * MR; ++i_) Ra[r_][i_] = *(const v4u*)(ga + (size_t)(32 * i_) * K + ko_); _Pragma("unroll") for (int i_ = 0; i_ < 2; ++i_) Rb[r_][i_] = *(const v4u*)(gb + (size_t)(32 * i_) * K + ko_); } while (0)
#define ST_STORE(b_, r_) do { LAS unsigned char* d_ = lds + (b_) * BUFB; _Pragma("unroll") for (int i_ = 0; i_ < 2 * MR; ++i_) *(LAS v4u*)(d_ + so + 32 * i_ * ST_STR) = Ra[r_][i_]; _Pragma("unroll") for (int i_ = 0; i_ < 2; ++i_) *(LAS v4u*)(d_ + BOFF + so + 32 * i_ * ST_STR) = Rb[r_][i_]; } while (0)
#define ST_COMP(b_) do { const LAS unsigned char* s_ = lds + (b_) * BUFB; _Pragma("unroll") for (int ks = 0; ks < 4; ++ks) { \
        const bf16x8 b0 = *(const LAS bf16x8*)(s_ + rb0 + ks * 64), b1 = *(const LAS bf16x8*)(s_ + rb1 + ks * 64); \
        _Pragma("unroll") for (int j = 0; j < MR; ++j) { const bf16x8 af = *(const LAS bf16x8*)(s_ + ra + j * 16 * ST_STR + ks * 64); acc[j][0] = MFMA16(b0, af, acc[j][0]); acc[j][1] = MFMA16(b1, af, acc[j][1]); } } } while (0)
#define ST_STEP(c_, k_) do { const int cc_ = (c_) + (k_); if (cc_ < nch) { ST_COMP(cc_ & 1); if (cc_ + 1 < nch) ST_STORE((cc_ + 1) & 1, ((k_) + 1) % NSET); if (cc_ + 1 + NSET < nch) ST_LOAD(cc_ + 1 + NSET, ((k_) + 1) % NSET); __syncthreads(); } } while (0)
    const int nch = K >> 7;
#pragma unroll
    for (int r = 0; r < NSET; ++r) if (r < nch) ST_LOAD(r, r);
    ST_STORE(0, 0); if (NSET < nch) ST_LOAD(NSET, 0);
    __syncthreads();
    for (int c = 0; c < nch; c += NSET) {
#pragma unroll
        for (int k = 0; k < NSET; ++k) ST_STEP(c, k);
    }
#undef ST_LOAD
#undef ST_STORE
#undef ST_COMP
#undef ST_STEP
#pragma unroll
    for (int j = 0; j < MR; ++j) { const int row = row0 + (mb * MR + j) * 16 + m, col = col0 + nh * 32 + kg * 4; E(row, col, acc[j][0]); E(row, col + 16, acc[j][1]); }
}
struct SEpiZ {
    bf16* Z; float* out;
    __device__ __forceinline__ void operator()(int row, int col, pg8::f32x4 v) const {
        const int region = col >> 9, r = row - MP; const float sc = region == 1 ? QSCALE : 1.f;
        v2u w; w.x = pkbf(v[0] * sc, v[1] * sc); w.y = pkbf(v[2] * sc, v[3] * sc); *(v2u*)(Z + (size_t)row * PROJ + col) = w;
        if (region >= 2) *(pg8::f32x4*)(out + (region == 2 ? O_KS : O_VS) + (size_t)r * 512 + (col - region * 512)) = v;
        else if (region == 0) *(pg8::f32x4*)(out + O_PS + (size_t)((r >> 3) * 15 + 7 + (r & 7)) * 512 + col) = v;
    }
};
struct SEpiPlain { bf16* O; int ldc;
    __device__ __forceinline__ void operator()(int row, int col, pg8::f32x4 v) const { v2u w; w.x = pkbf(v[0], v[1]); w.y = pkbf(v[2], v[3]); *(v2u*)(O + (size_t)row * ldc + col) = w; }
};

template <bool UPMAP = false> __device__ __forceinline__ void p0_transpose_item(const float* W, int K, int N, bf16* WT, LAS float* scr, int item, int lane) {
    const int nblk = N / 32, kb = item / nblk, nb = item % nblk, k0 = 64 * kb, n0 = 32 * nb;
    const int r0 = !UPMAP ? n0 : (n0 < FF ? 256 * (n0 >> 7) + (n0 & 127) : 256 * ((n0 - FF) >> 7) + 128 + ((n0 - FF) & 127));
#pragma unroll 8
    for (int i = 0; i < 32; ++i) { const int kk = 2 * i + (lane >> 5); scr[kk * 33 + (lane & 31)] = W[(size_t)(k0 + kk) * N + n0 + (lane & 31)]; }
    LDS_WAIT(); asm volatile("" ::: "memory");
    const int c = lane & 7;
#pragma unroll
    for (int j = 0; j < 4; ++j) { const int n = (lane >> 3) + 8 * j; const LAS float* s = scr + (8 * c) * 33 + n;
        v4u o; o.x = pkbf(s[0 * 33], s[1 * 33]); o.y = pkbf(s[2 * 33], s[3 * 33]); o.z = pkbf(s[4 * 33], s[5 * 33]); o.w = pkbf(s[6 * 33], s[7 * 33]);
        *(GAS v4u*)(WT + (size_t)(r0 + n) * K + k0 + 8 * c) = o; }
    LDS_WAIT(); asm volatile("" ::: "memory");
}
__device__ __forceinline__ float silu_f(float x) { return x * __builtin_amdgcn_rcpf(1.f + __builtin_amdgcn_exp2f(-1.4426950408889634f * x)); }
__device__ __forceinline__ void p0_mod_slice(const Args& a, LAS unsigned char* lds, int slice, int tid) {
    const int wave = __builtin_amdgcn_readfirstlane(tid >> 6), lane = tid & 63, n = lane & 15, kg = lane >> 4;
    const int kq = wave & 3, mh = wave >> 2, mb0 = mh ? 5 : 0, nmb = mh ? 4 : 5, c0 = slice * 32;
    const float* wada = a.in[I_WADA]; const float* cp = a.in[I_CP]; const float* cs = a.in[I_CS];
    pg8::f32x4 acc[5][2];
#pragma unroll
    for (int i = 0; i < 5; ++i) { acc[i][0] = (pg8::f32x4){0.f, 0.f, 0.f, 0.f}; acc[i][1] = acc[i][0]; }
    for (int ks = 0; ks < 8; ++ks) {
        const int k0 = kq * 256 + ks * 32 + kg * 8;
        bf16x8 bfr[2];
#pragma unroll
        for (int nb = 0; nb < 2; ++nb) { float w[8];
#pragma unroll
            for (int j = 0; j < 8; ++j) w[j] = wada[(size_t)(k0 + j) * MODW + c0 + nb * 16 + n];
            bfr[nb] = pack8((pg8::f32x4){w[0], w[1], w[2], w[3]}, (pg8::f32x4){w[4], w[5], w[6], w[7]}); }
#pragma unroll
        for (int mi = 0; mi < 5; ++mi) {
            if (mi < nmb) {
                const int row = (mb0 + mi) * 16 + n;
                pg8::f32x4 x0 = {0.f, 0.f, 0.f, 0.f}, x1 = x0;
                if (row < NMOD) { const float* cr = (row < NBP ? cp + (size_t)row * D : cs + (size_t)(row - NBP) * D) + k0; x0 = *(const pg8::f32x4*)cr; x1 = *(const pg8::f32x4*)(cr + 4); }
#pragma unroll
                for (int j = 0; j < 4; ++j) { x0[j] = silu_f(x0[j]); x1[j] = silu_f(x1[j]); }
                const bf16x8 af = pack8(x0, x1);
                acc[mi][0] = MFMA16(af, bfr[0], acc[mi][0]); acc[mi][1] = MFMA16(af, bfr[1], acc[mi][1]);
            }
        }
    }
    LAS float* P = (LAS float*)lds;
#pragma unroll
    for (int mi = 0; mi < 5; ++mi) if (mi < nmb) {
#pragma unroll
        for (int nb = 0; nb < 2; ++nb)
#pragma unroll
            for (int i = 0; i < 4; ++i) P[(kq * 144 + (mb0 + mi) * 16 + kg * 4 + i) * 32 + nb * 16 + n] = acc[mi][nb][i];
    }
    __syncthreads();
    float* mod = (float*)(a.ws + WS_MOD); const float* bada = a.in[I_BADA];
    for (int idx = tid; idx < NMOD * 32; idx += NWAVES * 64) { const int row = idx >> 5, col = idx & 31;
        const float v = ((P[(0 * 144 + row) * 32 + col] + P[(1 * 144 + row) * 32 + col]) + (P[(2 * 144 + row) * 32 + col] + P[(3 * 144 + row) * 32 + col])) + bada[c0 + col];
        mod[(size_t)row * MODW + c0 + col] = v; }
    __syncthreads();
}
__device__ __forceinline__ void p0_prologue(const Args& a, LAS unsigned char* lds, int tid, int G) {
    for (int s = blockIdx.x; s < MODW / 32; s += G) p0_mod_slice(a, lds, s, tid);
}
__device__ __forceinline__ void p0_weights(const Args& a, LAS unsigned char* lds, int tid, int G) {
    const int wave = __builtin_amdgcn_readfirstlane(tid >> 6), lane = tid & 63;
    LAS float* scr = (LAS float*)(lds + wave * 16384);
    const int gw = blockIdx.x * NWAVES + wave, NGW = G * NWAVES;
    constexpr int I_1 = (D / 64) * (PROJ / 32), I_2 = (D / 64) * (D / 32), I_3 = (D / 64) * (UPW / 32), I_4 = (FF / 64) * (D / 32), I_5 = 4 * 8;
    constexpr int NITEMS = I_1 + I_2 + I_3 + I_4 + I_5;
    for (int it = gw; it < NITEMS; it += NGW) {
        int r = it;
        if (r < I_1) { p0_transpose_item(a.in[I_WIN], D, PROJ, (bf16*)(a.ws + WS_WIN), scr, r, lane); continue; } r -= I_1;
        if (r < I_2) { p0_transpose_item(a.in[I_WOUT], D, D, (bf16*)(a.ws + WS_WOUT), scr, r, lane); continue; } r -= I_2;
        if (r < I_3) { p0_transpose_item<true>(a.in[I_WUP], D, UPW, (bf16*)(a.ws + WS_WUP), scr, r, lane); continue; } r -= I_3;
        if (r < I_4) { p0_transpose_item(a.in[I_WDN], FF, D, (bf16*)(a.ws + WS_WDN), scr, r, lane); continue; } r -= I_4;
        { const int g = r >> 3; p0_transpose_item(a.in[I_WPOOL] + (size_t)g * 16384, 128, 128, (bf16*)(a.ws + WS_WPOOL) + (size_t)g * 16384, scr, r & 7, lane); }
    }
}
__device__ __forceinline__ const float* x_row(const Args& a, int row) { return row < MP ? a.in[I_XP] + (size_t)row * D : a.in[I_XS] + (size_t)(row - MP) * D; }
__device__ __forceinline__ int mod_row(int row) { return row < MP ? (row >> 11) : NBP + ((row - MP) >> 3); }
__device__ __forceinline__ void unpk8(v4u w, f32x4& a, f32x4& b) { a = (f32x4){bflo(w.x), bfhi(w.x), bflo(w.y), bfhi(w.y)}; b = (f32x4){bflo(w.z), bfhi(w.z), bflo(w.w), bfhi(w.w)}; }
__device__ __forceinline__ v4u pk8(f32x4 a, f32x4 b) { v4u w; w.x = pkbf(a.x, a.y); w.y = pkbf(a.z, a.w); w.z = pkbf(b.x, b.y); w.w = pkbf(b.z, b.w); return w; }
__device__ __forceinline__ float ssq(f32x4 a) { return (a.x * a.x + a.y * a.y) + (a.z * a.z + a.w * a.w); }
__device__ __forceinline__ void p1_norm_in(const Args& a, int gw, int NGW, int lane) {
    const float* mod = (const float*)(a.ws + WS_MOD); const float* g = a.in[I_GPM]; bf16* XN = (bf16*)(a.ws + WS_XN);
    for (int row = gw; row < M; row += NGW) {
        const float* xr = x_row(a, row) + 8 * lane; const float* md = mod + (size_t)mod_row(row) * MODW;
        f32x4 v[2][2]; float ss = 0.f;
#pragma unroll
        for (int j = 0; j < 2; ++j) { v[j][0] = *(const GAS f32x4*)(xr + 512 * j); v[j][1] = *(const GAS f32x4*)(xr + 512 * j + 4); ss += ssq(v[j][0]) + ssq(v[j][1]); }
        const float rstd = 1.f / sqrtf(wave_sum(ss) * (1.f / D) + EPS);
#pragma unroll
        for (int j = 0; j < 2; ++j) { const int col = 8 * lane + 512 * j; f32x4 h[2];
#pragma unroll
            for (int q = 0; q < 2; ++q) { const f32x4 gg = *(const f32x4*)(g + col + 4 * q), sh = *(const f32x4*)(md + col + 4 * q), sc = *(const f32x4*)(md + D + col + 4 * q); h[q] = v[j][q] * rstd * gg * (sc + 1.f) + sh; }
            *(GAS v4u*)(XN + (size_t)row * D + col) = pk8(h[0], h[1]); }
    }
}
__device__ __forceinline__ void p6_norm_mid(const Args& a, int gw, int NGW, int lane) {
    const float* mod = (const float*)(a.ws + WS_MOD); const float* gq = a.in[I_GQM]; const float* gp = a.in[I_GPF];
    const bf16* MO = (const bf16*)(a.ws + WS_MO); bf16* XN = (bf16*)(a.ws + WS_XN); bf16* X1 = (bf16*)(a.ws + WS_X1);
    for (int row = gw; row < M; row += NGW) {
        const float* xr = x_row(a, row) + 8 * lane; const float* md = mod + (size_t)mod_row(row) * MODW;
        f32x4 v[2][2], mm[2][2]; float ss = 0.f;
#pragma unroll
        for (int j = 0; j < 2; ++j) { v[j][0] = *(const GAS f32x4*)(xr + 512 * j); v[j][1] = *(const GAS f32x4*)(xr + 512 * j + 4);
            unpk8(*(const GAS v4u*)(MO + (size_t)row * D + 8 * lane + 512 * j), mm[j][0], mm[j][1]); ss += ssq(mm[j][0]) + ssq(mm[j][1]); }
        const float rstd = 1.f / sqrtf(wave_sum(ss) * (1.f / D) + EPS);
        float s1 = 0.f;
#pragma unroll
        for (int j = 0; j < 2; ++j) { const int col = 8 * lane + 512 * j;
#pragma unroll
            for (int q = 0; q < 2; ++q) { const f32x4 gg = *(const f32x4*)(gq + col + 4 * q), gt = *(const f32x4*)(md + 2 * D + col + 4 * q); v[j][q] = v[j][q] + gt * (mm[j][q] * rstd * gg); s1 += ssq(v[j][q]); }
            *(GAS v4u*)(X1 + (size_t)row * D + col) = pk8(v[j][0], v[j][1]); }
        const float rstd1 = 1.f / sqrtf(wave_sum(s1) * (1.f / D) + EPS);
#pragma unroll
        for (int j = 0; j < 2; ++j) { const int col = 8 * lane + 512 * j; f32x4 h[2];
#pragma unroll
            for (int q = 0; q < 2; ++q) { const f32x4 gg = *(const f32x4*)(gp + col + 4 * q), sh = *(const f32x4*)(md + 3 * D + col + 4 * q), sc = *(const f32x4*)(md + 4 * D + col + 4 * q); h[q] = v[j][q] * rstd1 * gg * (sc + 1.f) + sh; }
            *(GAS v4u*)(XN + (size_t)row * D + col) = pk8(h[0], h[1]); }
    }
}
__device__ __forceinline__ void p10_norm_out(const Args& a, int gw, int NGW, int lane) {
    const float* mod = (const float*)(a.ws + WS_MOD); const float* gq = a.in[I_GQF]; const bf16* Fb = (const bf16*)(a.ws + WS_F); const bf16* X1 = (const bf16*)(a.ws + WS_X1);
    for (int row = gw; row < M; row += NGW) {
        const float* md = mod + (size_t)mod_row(row) * MODW;
        f32x4 v[2][2], mm[2][2]; float ss = 0.f;
#pragma unroll
        for (int j = 0; j < 2; ++j) { const size_t o = (size_t)row * D + 8 * lane + 512 * j;
            unpk8(*(const GAS v4u*)(X1 + o), v[j][0], v[j][1]); unpk8(*(const GAS v4u*)(Fb + o), mm[j][0], mm[j][1]); ss += ssq(mm[j][0]) + ssq(mm[j][1]); }
        const float rstd = 1.f / sqrtf(wave_sum(ss) * (1.f / D) + EPS);
        float* yo = a.out + O_Y + (size_t)row * D;
#pragma unroll
        for (int j = 0; j < 2; ++j) { const int col = 8 * lane + 512 * j;
#pragma unroll
            for (int q = 0; q < 2; ++q) { const f32x4 gg = *(const f32x4*)(gq + col + 4 * q), gt = *(const f32x4*)(md + 5 * D + col + 4 * q);
                *(GAS f32x4*)(yo + col + 4 * q) = v[j][q] + gt * (mm[j][q] * rstd * gg); } }
    }
}

__device__ __forceinline__ int rel_bucket(int dist) {
    if (dist < 16) return dist;
    int large = 16 + (int)(log((double)dist / 16.0) / log(8.0) * 16.0);
    return large < 31 ? large : 31;
}
__device__ __forceinline__ void build_bias_tables(const Args& a, LAS unsigned char* lds, int tid) {
    LAS float* RT = (LAS float*)(lds + RT_OFF); LAS float* BT = (LAS float*)(lds + BT_OFF); const float* rb = a.in[I_RELB];
    for (int i = tid; i < 4 * 128; i += NWAVES * 64) { const int h = i >> 7, d = i & 127; BT[i] = (rb[rel_bucket(d) * 4 + h] - rb[31 * 4 + h]) * LOG2E; }
    __syncthreads();
    for (int i = tid; i < 4 * RT_N; i += NWAVES * 64) { const int h = i / RT_N, idx = i % RT_N, dist = 447 - idx; RT[i] = (dist >= 0 && dist <= 127) ? BT[h * 128 + dist] : 0.f; }
    __syncthreads();
}
__device__ __forceinline__ float lam_value(const Args& a, int lane) {
    const float p1 = wave_sum(a.in[I_LQ1][lane] * a.in[I_LK1][lane]), p2 = wave_sum(a.in[I_LQ2][lane] * a.in[I_LK2][lane]);
    return expf(p1) - expf(p2) + LAM_INIT;
}
constexpr int SA_OSTR = 132;
__device__ __forceinline__ void sattn_unit(const Args& a, LAS unsigned char* lds, int s, int h, float lam, int tid) {
    const int wave = __builtin_amdgcn_readfirstlane(tid >> 6), lane = tid & 63, n = lane & 15, kg = lane >> 4, qi = n & 7, qc = n >> 3;
    const bf16* Z = (const bf16*)(a.ws + WS_Z); const float* ck = a.in[I_CK]; const float* cv = a.in[I_CV]; const int* pt = (const int*)a.in[I_PT] + s * NPAGES;
    const LAS float* BT = (const LAS float*)(lds + BT_OFF) + h * 128;
    bf16x8 qf[4];
#pragma unroll
    for (int ks = 0; ks < 4; ++ks) { v4u w = {0u, 0u, 0u, 0u};
        if ((ks >> 1) == qc) w = *(const v4u*)(Z + (size_t)(MP + s * TS + qi) * PROJ + 512 + h * 128 + qc * 64 + (ks & 1) * 32 + kg * 8);
        qf[ks] = __builtin_bit_cast(bf16x8, w); }
    pg8::f32x4 o[8];
#pragma unroll
    for (int vb = 0; vb < 8; ++vb) o[vb] = (pg8::f32x4){0.f, 0.f, 0.f, 0.f};
    float mrun = -INFINITY, lrun = 0.f;
    pg8::f32x4 kr[16], vv[8][2];
    LAS unsigned char* Kt = lds + wave * (32 * 272);
    const int kst = (lane >> 5) * 272 + (lane & 31) * 8, krd = n * 272 + kg * 16;
#define SA_LOADK(key0_) do { const int kk_ = (key0_); const float* kb_ = ck + ((size_t)(pt[kk_ >> 7] * PAGE + (kk_ & 127)) * 4 + h) * 128 + (size_t)(lane >> 5) * 512 + (lane & 31) * 4; \
        _Pragma("unroll") for (int i = 0; i < 16; ++i) kr[i] = *(const pg8::f32x4*)(kb_ + (size_t)i * 1024); } while (0)
#define SA_LOADV(key0_) do { const int kk_ = (key0_); const float* vb_ = cv + ((size_t)(pt[kk_ >> 7] * PAGE + (kk_ & 127)) * 4 + h) * 128; \
        _Pragma("unroll") for (int j = 0; j < 8; ++j) { const float* p_ = vb_ + (size_t)(16 * (j >> 2) + 4 * kg + (j & 3)) * 512 + 8 * n; vv[j][0] = *(const pg8::f32x4*)p_; vv[j][1] = *(const pg8::f32x4*)(p_ + 4); } } while (0)
    SA_LOADK(wave * 256); SA_LOADV(wave * 256);
    for (int tt = 0; tt < 8; ++tt) {
        const int key0 = wave * 256 + tt * 32;
        pg8::f32x4 sc[2];
#pragma unroll
        for (int i = 0; i < 16; ++i) { v2u w; w.x = pkbf(kr[i][0], kr[i][1]); w.y = pkbf(kr[i][2], kr[i][3]); *(LAS v2u*)(Kt + i * 544 + kst) = w; }
        if (tt < 7) SA_LOADK(key0 + 32);
#pragma unroll
        for (int b2 = 0; b2 < 2; ++b2) { sc[b2] = (pg8::f32x4){0.f, 0.f, 0.f, 0.f};
#pragma unroll
            for (int ks = 0; ks < 4; ++ks) sc[b2] = MFMA16(*(const LAS bf16x8*)(Kt + b2 * 16 * 272 + ks * 64 + krd), qf[ks], sc[b2]); }
        if (key0 >= PAST - 128) {
#pragma unroll
            for (int b2 = 0; b2 < 2; ++b2)
#pragma unroll
                for (int i = 0; i < 4; ++i) { int dist = PAST + qi - (key0 + b2 * 16 + kg * 4 + i); dist = dist > 127 ? 127 : dist; sc[b2][i] += BT[dist]; }
        }
        float mx = fmaxf(fmaxf(fmaxf(sc[0][0], sc[0][1]), fmaxf(sc[0][2], sc[0][3])), fmaxf(fmaxf(sc[1][0], sc[1][1]), fmaxf(sc[1][2], sc[1][3])));
        mx = fmaxf(mx, __shfl_xor(mx, 16)); mx = fmaxf(mx, __shfl_xor(mx, 32));
        const float mnew = fmaxf(mrun, mx), alpha = __builtin_amdgcn_exp2f(mrun - mnew); mrun = mnew;
        float ps = 0.f;
#pragma unroll
        for (int b2 = 0; b2 < 2; ++b2)
#pragma unroll
            for (int i = 0; i < 4; ++i) { sc[b2][i] = __builtin_amdgcn_exp2f(sc[b2][i] - mnew); ps += sc[b2][i]; }
        lrun = lrun * alpha + ps;
        const bf16x8 pf = pack8(sc[0], sc[1]);
#pragma unroll
        for (int vb = 0; vb < 8; ++vb) { o[vb] = o[vb] * alpha;
            o[vb] = MFMA16(pack8((pg8::f32x4){vv[0][vb >> 2][vb & 3], vv[1][vb >> 2][vb & 3], vv[2][vb >> 2][vb & 3], vv[3][vb >> 2][vb & 3]},
                                 (pg8::f32x4){vv[4][vb >> 2][vb & 3], vv[5][vb >> 2][vb & 3], vv[6][vb >> 2][vb & 3], vv[7][vb >> 2][vb & 3]}), pf, o[vb]); }
        if (tt < 7) SA_LOADV(key0 + 32);
    }
#undef SA_LOADK
#undef SA_LOADV
    if (wave == 0) {
        int l2 = lane; asm volatile("" : "+v"(l2)); const int n = l2 & 15, kg = l2 >> 4, qi = n & 7;
        const bf16* zr = Z + (size_t)(MP + s * TS) * PROJ;
        pg8::f32x4 sc0 = {0.f, 0.f, 0.f, 0.f};
#pragma unroll
        for (int ks = 0; ks < 4; ++ks) { v4u w = {0u, 0u, 0u, 0u};
            if (n < 8) w = *(const v4u*)(zr + (size_t)n * PROJ + 1024 + h * 128 + (ks >> 1) * 64 + (ks & 1) * 32 + kg * 8);
            sc0 = MFMA16(__builtin_bit_cast(bf16x8, w), qf[ks], sc0); }
#pragma unroll
        for (int i = 0; i < 4; ++i) { const int key = kg * 4 + i; const int dd = qi - key; sc0[i] = (key <= qi) ? sc0[i] + BT[dd < 0 ? 0 : dd] : -INFINITY; }
        float mx = fmaxf(fmaxf(sc0[0], sc0[1]), fmaxf(sc0[2], sc0[3]));
        mx = fmaxf(mx, __shfl_xor(mx, 16)); mx = fmaxf(mx, __shfl_xor(mx, 32));
        const float mnew = fmaxf(mrun, mx), alpha = __builtin_amdgcn_exp2f(mrun - mnew); mrun = mnew;
        float ps = 0.f;
#pragma unroll
        for (int i = 0; i < 4; ++i) { sc0[i] = __builtin_amdgcn_exp2f(sc0[i] - mnew); ps += sc0[i]; }
        lrun = lrun * alpha + ps;
        const bf16x8 pf = pack8(sc0, (pg8::f32x4){0.f, 0.f, 0.f, 0.f});
        v4u vk[4];
#pragma unroll
        for (int j = 0; j < 4; ++j) { vk[j] = (v4u){0u, 0u, 0u, 0u}; if (kg < 2) vk[j] = *(const v4u*)(zr + (size_t)(kg * 4 + j) * PROJ + 1536 + h * 128 + 8 * n); }
#pragma unroll
        for (int vb = 0; vb < 8; ++vb) { const int sh = (vb & 1) * 16; v4u w = {0u, 0u, 0u, 0u};
            w.x = ((vk[0][vb >> 1] >> sh) & 0xffffu) | (((vk[1][vb >> 1] >> sh) & 0xffffu) << 16); w.y = ((vk[2][vb >> 1] >> sh) & 0xffffu) | (((vk[3][vb >> 1] >> sh) & 0xffffu) << 16);
            o[vb] = o[vb] * alpha; o[vb] = MFMA16(__builtin_bit_cast(bf16x8, w), pf, o[vb]); }
    }
    lrun += __shfl_xor(lrun, 16); lrun += __shfl_xor(lrun, 32);
    __syncthreads();
    LAS float* OT = (LAS float*)lds; LAS float* ML = (LAS float*)(lds + 8 * 16 * SA_OSTR * 4);
    { int l3 = lane; asm volatile("" : "+v"(l3)); const int n = l3 & 15, kg = l3 >> 4;
#pragma unroll
    for (int i = 0; i < 4; ++i) { LAS float* op_ = OT + (wave * 16 + n) * SA_OSTR + 32 * kg + 8 * i;
        *(LAS pg8::f32x4*)op_ = (pg8::f32x4){o[0][i], o[1][i], o[2][i], o[3][i]}; *(LAS pg8::f32x4*)(op_ + 4) = (pg8::f32x4){o[4][i], o[5][i], o[6][i], o[7][i]}; }
    if (kg == 0) { ML[(wave * 16 + n) * 2] = mrun; ML[(wave * 16 + n) * 2 + 1] = lrun; } }
    __syncthreads();
    {
        const int i = wave; float oc[2][2];
#pragma unroll
        for (int c = 0; c < 2; ++c) { const int nn = c * 8 + i; float mxx = -INFINITY;
#pragma unroll
            for (int w2 = 0; w2 < 8; ++w2) mxx = fmaxf(mxx, ML[(w2 * 16 + nn) * 2]);
            float L = 0.f, A0 = 0.f, A1 = 0.f;
#pragma unroll
            for (int w2 = 0; w2 < 8; ++w2) { const float f = __builtin_amdgcn_exp2f(ML[(w2 * 16 + nn) * 2] - mxx); L += f * ML[(w2 * 16 + nn) * 2 + 1];
                A0 += f * OT[(w2 * 16 + nn) * SA_OSTR + lane]; A1 += f * OT[(w2 * 16 + nn) * SA_OSTR + 64 + lane]; }
            const float rl = 1.f / L; oc[c][0] = A0 * rl; oc[c][1] = A1 * rl; }
        const float r0 = oc[0][0] - lam * oc[1][0], r1 = oc[0][1] - lam * oc[1][1];
        const float rstd = 1.f / sqrtf(wave_sum(r0 * r0 + r1 * r1) * (1.f / 128.f) + EPS);
        const float* gh = a.in[I_GHEAD]; bf16* mix = (bf16*)(a.ws + WS_MIX) + (size_t)(MP + s * TS + i) * D + 512 + h * 128;
        mix[lane] = (bf16)(pkbf(r0 * rstd * gh[lane] * (1.f - LAM_INIT), 0.f) & 0xffffu);
        mix[lane + 64] = (bf16)(pkbf(r1 * rstd * gh[lane + 64] * (1.f - LAM_INIT), 0.f) & 0xffffu);
    }
    __syncthreads();
}
template <int W> __device__ __forceinline__ void pool_window(const float (&e0)[23], const float (&e1)[23], int pos0  , unsigned (&dpk)[8]) {
    float s0 = 0.f, s1 = 0.f;
#pragma unroll
    for (int r = 16 - W; r <= 15; ++r) { s0 += e0[r]; s1 += e1[r]; }
#pragma unroll
    for (int i = 0; i < 8; ++i) {
        if (i > 0) { s0 += e0[15 + i] - e0[15 + i - W]; s1 += e1[15 + i] - e1[15 + i - W]; }
        float cnt = (float)W; if (pos0 >= 0) { const int c = pos0 + i + 1; cnt = (float)(c < W ? c : W); }
        const float rc = 1.f / cnt;
        dpk[i] = pkbf(s0 * rc - e0[15 + i], s1 * rc - e1[15 + i]);
    }
}
constexpr int PD_STR = 136;
__device__ __forceinline__ void pool_item(const Args& a, LAS unsigned char* lds, int item, int tid) {
    int tid_ = tid; asm volatile("" : "+v"(tid_));
    const int wave = __builtin_amdgcn_readfirstlane(tid_ >> 6), lane = tid_ & 63, n = lane & 15, kg = lane >> 4;
    const int tile = item >> 2, g = item & 3, row0 = tile * 64 + wave * 8;
    const bf16* Z = (const bf16*)(a.ws + WS_Z);
    float e0[23], e1[23]; int pos0;
    if (row0 < MP) {
        const int t0 = row0 & (TP - 1); pos0 = t0;
#pragma unroll
        for (int r = 0; r < 23; ++r) { const int t = t0 - 15 + r; unsigned w = 0u;
            if (t >= 0) w = *(const unsigned*)(Z + (size_t)(row0 - 15 + r) * PROJ + g * 128 + 2 * lane);
            e0[r] = bflo(w); e1[r] = bfhi(w); }
    } else {
        const int s = (row0 - MP) >> 3; pos0 = -1; const float* sp = a.in[I_SP] + (size_t)s * 15 * 512 + g * 128 + 2 * lane;
#pragma unroll
        for (int r = 0; r < 15; ++r) { const f32x2 v = *(const f32x2*)(sp + (size_t)r * 512); e0[r] = v.x; e1[r] = v.y; }
#pragma unroll
        for (int r = 15; r < 23; ++r) { const unsigned w = *(const unsigned*)(Z + (size_t)(row0 + r - 15) * PROJ + g * 128 + 2 * lane); e0[r] = bflo(w); e1[r] = bfhi(w); }
        float* ps = a.out + O_PS + (size_t)s * 15 * 512 + g * 128 + 2 * lane;
#pragma unroll
        for (int r = 8; r < 15; ++r) *(f32x2*)(ps + (size_t)(r - 8) * 512) = (f32x2){e0[r], e1[r]};
    }
    unsigned dpk[8];
    if (g == 0) pool_window<2>(e0, e1, pos0, dpk); else if (g == 1) pool_window<4>(e0, e1, pos0, dpk); else if (g == 2) pool_window<8>(e0, e1, pos0, dpk); else pool_window<16>(e0, e1, pos0, dpk);
    LAS bf16* Dt = (LAS bf16*)lds;
#pragma unroll
    for (int i = 0; i < 8; ++i) *(LAS unsigned*)(Dt + (wave * 8 + i) * PD_STR + 2 * lane) = dpk[i];
    __syncthreads();
    const int rb = wave & 3, ch = wave >> 2;
    const bf16* wp = (const bf16*)(a.ws + WS_WPOOL) + (size_t)g * 16384;
    pg8::f32x4 acc[4];
#pragma unroll
    for (int nb = 0; nb < 4; ++nb) acc[nb] = (pg8::f32x4){0.f, 0.f, 0.f, 0.f};
#pragma unroll
    for (int ks = 0; ks < 4; ++ks) {
        const bf16x8 af = *(const LAS bf16x8*)(Dt + (rb * 16 + n) * PD_STR + ks * 32 + kg * 8);
#pragma unroll
        for (int nb = 0; nb < 4; ++nb) { const bf16x8 bf_ = *(const bf16x8*)(wp + (size_t)(ch * 64 + nb * 16 + n) * 128 + ks * 32 + kg * 8); acc[nb] = MFMA16(af, bf_, acc[nb]); }
    }
    const float* psc = a.in[I_PSCALE] + g * 128; bf16* mix = (bf16*)(a.ws + WS_MIX);
#pragma unroll
    for (int nb = 0; nb < 4; ++nb) { const int col = ch * 64 + nb * 16 + n; const float sc = psc[col];
#pragma unroll
        for (int i = 0; i < 4; ++i) mix[(size_t)(tile * 64 + rb * 16 + kg * 4 + i) * D + g * 128 + col] = (bf16)(pkbf(acc[nb][i] * sc, 0.f) & 0xffffu); }
    __syncthreads();
}
__device__ __forceinline__ void p4_combine(const Args& a, int gw, int NGW, int lane) {
    const float lam = lam_value(a, lane); const float* gh = a.in[I_GHEAD];
    const bf16* OB = (const bf16*)(a.ws + WS_OB); bf16* mix = (bf16*)(a.ws + WS_MIX);
    const int h = lane >> 4, vd0 = (lane & 15) * 8;
    const f32x4 g0 = *(const f32x4*)(gh + vd0), g1 = *(const f32x4*)(gh + vd0 + 4);
    for (int row = gw; row < MP; row += NGW) {
        const v4u w0 = *(const v4u*)(OB + (size_t)row * D + h * 256 + vd0), w1 = *(const v4u*)(OB + (size_t)row * D + h * 256 + 128 + vd0);
        float o[8];
        o[0] = bflo(w0.x) - lam * bflo(w1.x); o[1] = bfhi(w0.x) - lam * bfhi(w1.x); o[2] = bflo(w0.y) - lam * bflo(w1.y); o[3] = bfhi(w0.y) - lam * bfhi(w1.y);
        o[4] = bflo(w0.z) - lam * bflo(w1.z); o[5] = bfhi(w0.z) - lam * bfhi(w1.z); o[6] = bflo(w0.w) - lam * bflo(w1.w); o[7] = bfhi(w0.w) - lam * bfhi(w1.w);
        float ss = 0.f;
#pragma unroll
        for (int j = 0; j < 8; ++j) ss += o[j] * o[j];
        ss += __shfl_xor(ss, 1); ss += __shfl_xor(ss, 2); ss += __shfl_xor(ss, 4); ss += __shfl_xor(ss, 8);
        const float r = (1.f - LAM_INIT) / sqrtf(ss * (1.f / 128.f) + EPS);
        v4u w; w.x = pkbf(o[0] * r * g0.x, o[1] * r * g0.y); w.y = pkbf(o[2] * r * g0.z, o[3] * r * g0.w); w.z = pkbf(o[4] * r * g1.x, o[5] * r * g1.y); w.w = pkbf(o[6] * r * g1.z, o[7] * r * g1.w);
        *(v4u*)(mix + (size_t)row * D + 512 + h * 128 + vd0) = w;
    }
}
__device__ __forceinline__ void unpack8(v4u w, float (&f)[8]) { f[0] = bflo(w.x); f[1] = bfhi(w.x); f[2] = bflo(w.y); f[3] = bfhi(w.y); f[4] = bflo(w.z); f[5] = bfhi(w.z); f[6] = bflo(w.w); f[7] = bfhi(w.w); }
__device__ __forceinline__ void p8_conv_geglu(const Args& a, int gtid, int NT) {
    const bf16* U = (const bf16*)(a.ws + WS_U); bf16* ACT = (bf16*)(a.ws + WS_ACT);
    const float* cw = a.in[I_CONVW]; const float* cb = a.in[I_CONVB]; const float* stc = a.in[I_SC];
    constexpr int NCH = FF / 8, NRUN = MS / 8;
    for (int it = gtid; it < NRUN * NCH; it += NT) {
        const int run = MP / 8 + it / NCH, j0 = (it % NCH) * 8, row0 = run * 8, ug = 256 * (j0 >> 7) + (j0 & 127), uv = ug + 128;
        float wg[3][8], wv[3][8], bg[8], bv[8];
#pragma unroll
        for (int k = 0; k < 3; ++k) { const f32x4 a0 = *(const f32x4*)(cw + k * UPW + j0), a1 = *(const f32x4*)(cw + k * UPW + j0 + 4), b0 = *(const f32x4*)(cw + k * UPW + FF + j0), b1 = *(const f32x4*)(cw + k * UPW + FF + j0 + 4);
            wg[k][0] = a0.x; wg[k][1] = a0.y; wg[k][2] = a0.z; wg[k][3] = a0.w; wg[k][4] = a1.x; wg[k][5] = a1.y; wg[k][6] = a1.z; wg[k][7] = a1.w;
            wv[k][0] = b0.x; wv[k][1] = b0.y; wv[k][2] = b0.z; wv[k][3] = b0.w; wv[k][4] = b1.x; wv[k][5] = b1.y; wv[k][6] = b1.z; wv[k][7] = b1.w; }
        { const f32x4 a0 = *(const f32x4*)(cb + j0), a1 = *(const f32x4*)(cb + j0 + 4), b0 = *(const f32x4*)(cb + FF + j0), b1 = *(const f32x4*)(cb + FF + j0 + 4);
            bg[0] = a0.x; bg[1] = a0.y; bg[2] = a0.z; bg[3] = a0.w; bg[4] = a1.x; bg[5] = a1.y; bg[6] = a1.z; bg[7] = a1.w;
            bv[0] = b0.x; bv[1] = b0.y; bv[2] = b0.z; bv[3] = b0.w; bv[4] = b1.x; bv[5] = b1.y; bv[6] = b1.z; bv[7] = b1.w; }
        float g2[8], g1[8], v2[8], v1[8];
        if (row0 < MP) {
            if ((row0 & (TP - 1)) == 0) {
#pragma unroll
                for (int j = 0; j < 8; ++j) { g2[j] = 0.f; g1[j] = 0.f; v2[j] = 0.f; v1[j] = 0.f; }
            } else {
                unpack8(*(const v4u*)(U + (size_t)(row0 - 2) * UPW + ug), g2); unpack8(*(const v4u*)(U + (size_t)(row0 - 1) * UPW + ug), g1);
                unpack8(*(const v4u*)(U + (size_t)(row0 - 2) * UPW + uv), v2); unpack8(*(const v4u*)(U + (size_t)(row0 - 1) * UPW + uv), v1);
            }
        } else {
            const float* sp = stc + (size_t)((row0 - MP) >> 3) * 2 * UPW + j0;
#pragma unroll
            for (int j = 0; j < 8; ++j) { g2[j] = sp[j]; g1[j] = sp[UPW + j]; v2[j] = sp[FF + j]; v1[j] = sp[UPW + FF + j]; }
        }
#pragma unroll
        for (int i = 0; i < 8; ++i) {
            float g0[8], v0[8];
            unpack8(*(const v4u*)(U + (size_t)(row0 + i) * UPW + ug), g0); unpack8(*(const v4u*)(U + (size_t)(row0 + i) * UPW + uv), v0);
            float r[8];
#pragma unroll
            for (int j = 0; j < 8; ++j) { const float cg = bg[j] + wg[0][j] * g2[j] + wg[1][j] * g1[j] + wg[2][j] * g0[j], cv = bv[j] + wv[0][j] * v2[j] + wv[1][j] * v1[j] + wv[2][j] * v0[j];
                r[j] = gelu_tanh(cg) * cv; g2[j] = g1[j]; g1[j] = g0[j]; v2[j] = v1[j]; v1[j] = v0[j]; }
            v4u w; w.x = pkbf(r[0], r[1]); w.y = pkbf(r[2], r[3]); w.z = pkbf(r[4], r[5]); w.w = pkbf(r[6], r[7]);
            *(v4u*)(ACT + (size_t)(row0 + i) * FF + j0) = w;
        }
    }
}

__device__ __forceinline__ void p8_fixup_prompt(const Args& a, int gtid, int NT) {
    const float* UH = (const float*)(a.ws + WS_UH); bf16* ACT = (bf16*)(a.ws + WS_ACT); const float* cw = a.in[I_CONVW]; const float* cb = a.in[I_CONVB];
    constexpr int NCH = FF / 8;
    for (int it = gtid; it < 56 * 2 * NCH; it += NT) {
        const int pidx = it / (2 * NCH), rem = it % (2 * NCH), r = rem / NCH, j0 = (rem % NCH) * 8, pm = (pidx / 7) * 8 + pidx % 7 + 1;
        const float* hp = UH + (size_t)(pm - 1) * 4 * UPW; const float* hc = UH + (size_t)pm * 4 * UPW;
        const float* r2 = r == 0 ? hp + 2 * UPW : hp + 3 * UPW;
        const float* r1 = r == 0 ? hp + 3 * UPW : hc;
        const float* r0 = r == 0 ? hc : hc + UPW;
        float res[8];
#pragma unroll
        for (int j = 0; j < 8; ++j) { const int cg = j0 + j, cvv = FF + j0 + j;
            const float g = cb[cg] + cw[cg] * r2[cg] + cw[UPW + cg] * r1[cg] + cw[2 * UPW + cg] * r0[cg];
            const float v = cb[cvv] + cw[cvv] * r2[cvv] + cw[UPW + cvv] * r1[cvv] + cw[2 * UPW + cvv] * r0[cvv];
            res[j] = gelu_tanh(g) * v; }
        v4u w; w.x = pkbf(res[0], res[1]); w.y = pkbf(res[2], res[3]); w.z = pkbf(res[4], res[5]); w.w = pkbf(res[6], res[7]);
        *(v4u*)(ACT + (size_t)(pm * 256 + r) * FF + j0) = w;
    }
}

#ifndef P3_SUB
#define P3_SUB 7
#endif
#ifndef RP_SATTN
#define RP_SATTN 1
#endif
#ifndef RP_PATTN
#define RP_PATTN 1
#endif
#ifndef RP_THIN
#define RP_THIN 1
#endif
#ifndef RP_SMALL
#define RP_SMALL 1
#endif
#ifndef RP_G2
#define RP_G2 1
#endif
#ifndef RP_G5
#define RP_G5 1
#endif
#ifndef RP_G9
#define RP_G9 1
#endif
#ifndef RP_G7
#define RP_G7 1
#endif
#ifndef RP_P0
#define RP_P0 1
#endif
constexpr int N_PHASES = 11;
__global__ void __launch_bounds__(NWAVES * 64, 2) fwd_kernel(Args args) {
    extern __shared__ __attribute__((aligned(16))) unsigned char lds_raw[];
    LAS unsigned char* lds = (LAS unsigned char*)lds_raw;
    const int G = gridDim.x, bx = blockIdx.x, vcu = (G % 8 == 0) ? (bx % 8) * (G / 8) + bx / 8 : bx;
    const int NGW = G * NWAVES;
#define IDS() int tid = threadIdx.x; asm volatile("" : "+v"(tid)); const int lane = tid & 63, wave = __builtin_amdgcn_readfirstlane(tid >> 6), gw = bx * NWAVES + wave; (void)lane; (void)wave; (void)gw
    for (int u = threadIdx.x; u < (LDS_BYTES - LDSCTL_OFF) / 4; u += NWAVES * 64) ((LAS unsigned*)(lds + LDSCTL_OFF))[u] = 0u;
    __syncthreads();
    volatile LAS unsigned* MISC = (volatile LAS unsigned*)(lds + MISC_OFF);
    unsigned* ctl = (unsigned*)(args.ws + WS_CTL);
    const bool use_bar = (args.ph_hi - args.ph_lo) > 1;
    XcdBarrier bar; bar.bar = ctl + CW_BAR; bar.x = 0; bar.st = nullptr;
    if (use_bar) bar = xcd_barrier_post(ctl + CW_BAR, MISC + 8);
    const int lo = args.ph_lo, hi = args.ph_hi;
#ifndef PH_MASK
#define PH_MASK 0xFFFF
#endif
#define IN(k) (((PH_MASK >> (k)) & 1) && lo <= (k) && (k) < hi)
#ifndef RP_BAR
#define RP_BAR 1
#endif
#define SEAM(k) do { if (IN(k) && IN((k) + 1)) { for (int rb_ = 0; rb_ < RP_BAR; ++rb_) xcd_barrier(bar); } } while (0)
#define WSP(off) ((bf16*)(args.ws + (off)))
#define ST_ROWT(t) (((((t) & 7) >> 2) << 3) + ((((t) & 255) >> 3) & 7))
#define ST_COLT(t) ((((t) >> 8) << 4) + ((((t) & 7) & 3) << 2) + ((((t) & 255) >> 3) >> 3))

    if (IN(0)) { IDS(); for (int rp = 0; rp < RP_P0; ++rp) p0_prologue(args, lds, tid, G); } SEAM(0);
    if (IN(1)) { IDS(); p0_weights(args, lds, tid, G); for (int rp = 0; rp < RP_THIN; ++rp) p1_norm_in(args, gw, NGW, lane); } SEAM(1);
    if (IN(2)) {
        pg8::Gemm g{WSP(WS_XN), WSP(WS_WIN), MP, PROJ, D}; pg8::StaticOrder S; S.init(MP, PROJ, G, bx);
        EpiZ E{WSP(WS_Z), args.out};
        for (int rp = 0; rp < RP_G2; ++rp) pg8::gemm_phase<EpiZ, pg8::StaticOrder, true, true>(lds, g, S, E);
        { IDS(); SEpiZ SE{WSP(WS_Z), args.out};
          for (int rp = 0; rp < RP_SMALL; ++rp) for (int t = bx; t < (MS / 128) * (PROJ / 64); t += G) gemm_small_tile<SEpiZ, 2>(lds, WSP(WS_XN), WSP(WS_WIN), D, MP + ((t >> 3) & 7) * 128, (4 * (t & 7) + ((t & 255) >> 6)) * 64, tid, SE); }
    } SEAM(2);
    if (IN(3)) {
        { IDS(); build_bias_tables(args, lds, tid); }
        if ((P3_SUB & 2) && (vcu & 1)) { IDS(); const float lam = lam_value(args, lane); for (int rp = 0; rp < RP_SATTN; ++rp) for (int u = vcu; u < NBS * 4; u += G) sattn_unit(args, lds, u >> 2, u & 3, lam, tid); }
        {
            const int bh = vcu >> 3, b = bh >> 2, h = bh & 3, c = vcu & 1, vh = (vcu >> 1) & 1, hs = (vcu >> 2) & 1;
            if ((P3_SUB & 1) && vcu < 256) {
                for (int i_ = 0; i_ < 4 * RP_PATTN; ++i_) { const int i = i_ & 3;
                    const int qb = hs ? ((i == 0) ? 2 : (i == 1) ? 5 : (i == 2) ? 3 : 4) : ((i == 0) ? 0 : (i == 1) ? 7 : (i == 2) ? 1 : 6);
                    attn_body::attn_unit<8>((long)b * TP, 512 + h * 128 + c * 64, 1024 + h * 128 + c * 64, 1536 + h * 128 + vh * 64, h * 256 + c * 128 + vh * 64, qb,
                                            (const attn_body::bf16*)(args.ws + WS_Z), (attn_body::bf16*)(args.ws + WS_OB), (char*)lds_raw, (attn_body::lds_cfptr)(lds + RT_OFF) + h * RT_N);
                }
            }
        }
        if ((P3_SUB & 2) && !(vcu & 1)) { IDS(); const float lam = lam_value(args, lane); for (int rp = 0; rp < RP_SATTN; ++rp) for (int u = vcu; u < NBS * 4; u += G) sattn_unit(args, lds, u >> 2, u & 3, lam, tid); }
        if (P3_SUB & 4) { IDS(); for (int rp = 0; rp < RP_THIN; ++rp) for (int it = vcu; it < (M / 64) * 4; it += G) pool_item(args, lds, it, tid); }
    } SEAM(3);
    if (IN(4)) { IDS(); for (int rp = 0; rp < RP_THIN; ++rp) p4_combine(args, gw, NGW, lane); } SEAM(4);
    if (IN(5)) {
        pg8::Gemm g{WSP(WS_MIX), WSP(WS_WOUT), MP, D, D}; pg8::StaticOrder S; S.init(MP, D, G, bx);
        EpiPlain E{WSP(WS_MO), D};
        for (int rp = 0; rp < RP_G5; ++rp) pg8::gemm_phase<EpiPlain, pg8::StaticOrder, true, true>(lds, g, S, E);
        { IDS(); SEpiPlain SE{WSP(WS_MO), D};
          for (int rp = 0; rp < RP_SMALL; ++rp) for (int t = bx; t < (MS / 64) * (D / 64); t += G) gemm_small_tile(lds, WSP(WS_MIX), WSP(WS_WOUT), D, MP + ST_ROWT(t) * 64, ST_COLT(t) * 64, tid, SE); }
    } SEAM(5);
    if (IN(6)) { IDS(); for (int rp = 0; rp < RP_THIN; ++rp) p6_norm_mid(args, gw, NGW, lane); } SEAM(6);
    if (IN(7)) {
        pg8::Gemm g{WSP(WS_XN), WSP(WS_WUP), M, UPW, D}; pg8::StaticOrder S; S.init(M, UPW, G, bx);
        EpiConvGlu E{WSP(WS_U), WSP(WS_ACT), (float*)(args.ws + WS_UH), args.out, args.in[I_CONVW], args.in[I_CONVB], lds + RING_BYTES + 512};
        for (int rp = 0; rp < RP_G7; ++rp) pg8::gemm_phase<EpiConvGlu, pg8::StaticOrder, true, true>(lds, g, S, E);
    } SEAM(7);
    if (IN(8)) { IDS(); p8_fixup_prompt(args, bx * NWAVES * 64 + tid, G * NWAVES * 64); for (int rp = 0; rp < RP_THIN; ++rp) p8_conv_geglu(args, bx * NWAVES * 64 + tid, G * NWAVES * 64); } SEAM(8);
    if (IN(9)) {
        pg8::Gemm g{WSP(WS_ACT), WSP(WS_WDN), MP, D, FF}; pg8::StaticOrder S; S.init(MP, D, G, bx);
        EpiPlain E{WSP(WS_F), D};
        for (int rp = 0; rp < RP_G9; ++rp) pg8::gemm_phase<EpiPlain, pg8::StaticOrder, true, true>(lds, g, S, E);
        { IDS(); SEpiPlain SE{WSP(WS_F), D};
          for (int rp = 0; rp < RP_SMALL; ++rp) for (int t = bx; t < (MS / 64) * (D / 64); t += G) gemm_small_tile(lds, WSP(WS_ACT), WSP(WS_WDN), FF, MP + ST_ROWT(t) * 64, ST_COLT(t) * 64, tid, SE); }
    } SEAM(9);
    if (IN(10)) { IDS(); p10_norm_out(args, gw, NGW, lane); }
#undef IN
#undef SEAM
}

#ifndef MK_N_LAUNCHES
#define MK_N_LAUNCHES 1
#endif
static_assert((size_t)(CW_BAR + XCD_BAR_WORDS) * 4 <= CTL_ZERO_BYTES, "the per-call memset covers every barrier word");
extern "C" void kernel_launch(void* const* d_in, const int* in_sizes, int n_in, void* d_out, int out_size, void* d_ws, size_t ws_size, hipStream_t stream) {
    static int grid = 0;
    if (grid == 0) {
        if (n_in != 29 || (size_t)out_size != O_END || ws_size < WS_END) { fprintf(stderr, "kernel_launch: unexpected shapes (n_in %d, out %d, ws %zu); nothing launched\n", n_in, out_size, ws_size); grid = -1; return; }
        int dev = 0, cus = 0, per_cu = 0;
        if (hipGetDevice(&dev) != hipSuccess || hipDeviceGetAttribute(&cus, hipDeviceAttributeMultiprocessorCount, dev) != hipSuccess) { grid = -1; return; }
        if (hipFuncSetAttribute((const void*)fwd_kernel, hipFuncAttributeMaxDynamicSharedMemorySize, LDS_BYTES) != hipSuccess) { fprintf(stderr, "kernel_launch: hipFuncSetAttribute failed\n"); grid = -1; return; }
        if (hipOccupancyMaxActiveBlocksPerMultiprocessor(&per_cu, (const void*)fwd_kernel, NWAVES * 64, LDS_BYTES) != hipSuccess || per_cu < 1) { fprintf(stderr, "kernel_launch: occupancy query reports %d workgroups per CU\n", per_cu); }
        (void)hipGetLastError();
        grid = cus;
        if (grid != 256) fprintf(stderr, "kernel_launch: %d CUs (expected 256)\n", grid);
    }
    if (grid < 0) return;
    (void)hipMemsetAsync((char*)d_ws + WS_CTL, 0, CTL_ZERO_BYTES, stream);
    Args a{};
    for (int i = 0; i < 29; ++i) a.in[i] = (const float*)d_in[i];
    a.out = (float*)d_out; a.ws = (unsigned char*)d_ws;
#if MK_N_LAUNCHES == 1
    a.ph_lo = 0; a.ph_hi = N_PHASES;
    hipLaunchKernelGGL(fwd_kernel, dim3(grid), dim3(NWAVES * 64), LDS_BYTES, stream, a);
#else
    for (int p = 0; p < N_PHASES; ++p) { a.ph_lo = p; a.ph_hi = p + 1; hipLaunchKernelGGL(fwd_kernel, dim3(grid), dim3(NWAVES * 64), LDS_BYTES, stream, a); }
#endif
}
```
